# Optimizing an MI355X kernel written in HIP

```python
import jax, jax.numpy as jnp
from jax import lax
import numpy as np

D_MODEL = 1024
BATCH = 32
SEQ = 2048
DEPTH = 2

GRID_W = 64
CTX_LEN = 256
EPS = 1e-6
POOL_WINDOWS = (2, 4, 8, 16)
POOL_GROUPS = len(POOL_WINDOWS)
POOL_GROUP_DIM = D_MODEL // 8
POOL_WIDTH = POOL_GROUPS * POOL_GROUP_DIM
SGU_HEADS = 4
SGU_HEAD_DIM = D_MODEL // 8
SGU_WIDTH = SGU_HEADS * SGU_HEAD_DIM
CHUNK = 128
AB_IN = 2 * POOL_WIDTH + 3 * SGU_WIDTH
AB_MIX = POOL_WIDTH + SGU_WIDTH
FNET_HEADS = 4
FNET_HEAD_DIM = D_MODEL // 8
FNET_WIDTH = FNET_HEADS * FNET_HEAD_DIM
MLA_HEADS = 8
QK_NOPE = 64
QK_ROPE = 32
V_DIM = 64
Q_LORA = D_MODEL // 4
KV_LORA = D_MODEL // 8
MLA_WIDTH = MLA_HEADS * V_DIM
CD_IN = 2 * FNET_WIDTH + Q_LORA + KV_LORA + QK_ROPE + MLA_WIDTH
CD_MIX = FNET_WIDTH + MLA_WIDTH
ROPE_AXIS = QK_ROPE // 2
ROPE_BASE = 10000.0
Q_BLOCK = 128
ALPHA = (2 * DEPTH) ** 0.25
BETA = (8 * DEPTH) ** -0.25
N_EVEN = (DEPTH + 1) // 2
N_ODD = DEPTH // 2

kernel_name = "hybrid_pool_sgu_fnet_mla_diffusion_block"


def _layer_norm(x, g, b):
    xf = x.astype(jnp.float32)
    mu = jnp.mean(xf, axis=-1, keepdims=True)
    var = jnp.mean(jnp.square(xf - mu), axis=-1, keepdims=True)
    return ((xf - mu) * lax.rsqrt(var + EPS) * g + b).astype(x.dtype)


def _rms_norm(x, g):
    xf = x.astype(jnp.float32)
    y = xf * lax.rsqrt(jnp.mean(jnp.square(xf), axis=-1, keepdims=True) + EPS)
    return (y * g).astype(x.dtype)


def _adaln(cond, w_mod, b_mod):
    m = jax.nn.silu(cond) @ w_mod + b_mod
    return jnp.split(m, 3, axis=-1)


def _post_norm(x, y, gate, g, b):
    return _layer_norm(ALPHA * x + gate * y, g, b)


def _multiscale_pool(a, pool_w, pool_scale):
    bn, L, _ = a.shape
    cs = jnp.cumsum(a.astype(jnp.float32), axis=1)
    cs = jnp.pad(cs, ((0, 0), (1, 0), (0, 0)))
    t = jnp.arange(L)
    outs = []
    for g, w in enumerate(POOL_WINDOWS):
        lo = jnp.clip(t - w // 2, 0, L)
        hi = jnp.clip(t + w - w // 2, 0, L)
        seg = cs[:, :, g * POOL_GROUP_DIM:(g + 1) * POOL_GROUP_DIM]
        s = jnp.take(seg, hi, axis=1) - jnp.take(seg, lo, axis=1)
        outs.append(s / (hi - lo).astype(jnp.float32)[None, :, None])
    pooled = jnp.concatenate(outs, axis=-1).astype(a.dtype)
    d = (pooled - a).reshape(bn, L, POOL_GROUPS, POOL_GROUP_DIM)
    y = jnp.einsum('blgc,gcd->blgd', d, pool_w).reshape(bn, L, POOL_WIDTH)
    return y * pool_scale


def _chunk_sgu(u, v, w_s, b_s):
    bn, L, _ = v.shape
    nc = L // CHUNK
    vh = v.reshape(bn, L, SGU_HEADS, SGU_HEAD_DIM).astype(jnp.float32)
    mu = jnp.mean(vh, axis=-1, keepdims=True)
    var = jnp.mean(jnp.square(vh - mu), axis=-1, keepdims=True)
    vn = ((vh - mu) * lax.rsqrt(var + EPS)).astype(v.dtype)
    vn = vn.reshape(bn, nc, CHUNK, SGU_HEADS, SGU_HEAD_DIM)
    f = jnp.einsum('hij,bnjhc->bnihc', w_s, vn) + jnp.swapaxes(b_s, 0, 1)[:, :, None]
    return u * f.reshape(bn, L, SGU_WIDTH)


def _ab_mixer(h, w_in, pool_w, pool_scale, sgu_w, sgu_b, w_out):
    z = h @ w_in
    a, ga, u, v, gb = jnp.split(z, [POOL_WIDTH, 2 * POOL_WIDTH, 2 * POOL_WIDTH + SGU_WIDTH,
                                    2 * POOL_WIDTH + 2 * SGU_WIDTH], axis=-1)
    ya = _multiscale_pool(a, pool_w, pool_scale) * jax.nn.silu(ga)
    yb = _chunk_sgu(u, v, sgu_w, sgu_b) * jax.nn.silu(gb)
    return jnp.concatenate([ya, yb], axis=-1) @ w_out


def _fourier_mix(f, w_f):
    bn, L, _ = f.shape
    fh = f.reshape(bn, L, FNET_HEADS, FNET_HEAD_DIM).astype(jnp.float32)
    spec = jnp.fft.fft2(fh, axes=(1, 3), norm="ortho").real
    return spec.astype(f.dtype).reshape(bn, L, FNET_WIDTH) @ w_f


def _axial_tables(L, dtype):
    rows = L // GRID_W
    row = jnp.repeat(jnp.arange(rows), GRID_W).astype(jnp.float32)
    col = jnp.tile(jnp.arange(GRID_W), rows).astype(jnp.float32)
    inv = ROPE_BASE ** (-jnp.arange(0, ROPE_AXIS, 2, dtype=jnp.float32) / ROPE_AXIS)
    ang_r = (row[:, None] * inv)[:, None, :]
    ang_c = (col[:, None] * inv)[:, None, :]
    return (jnp.cos(ang_r).astype(dtype), jnp.sin(ang_r).astype(dtype),
            jnp.cos(ang_c).astype(dtype), jnp.sin(ang_c).astype(dtype))


def _rotate(x, cos, sin):
    half = x.shape[-1] // 2
    x1, x2 = x[..., :half], x[..., half:]
    return jnp.concatenate([x1 * cos - x2 * sin, x1 * sin + x2 * cos], axis=-1)


def _axial_rope(x, rope):
    cos_r, sin_r, cos_c, sin_c = rope
    return jnp.concatenate([_rotate(x[..., :ROPE_AXIS], cos_r, sin_r),
                            _rotate(x[..., ROPE_AXIS:], cos_c, sin_c)], axis=-1)


def _split_cd(z):
    o1 = FNET_WIDTH
    o2 = o1 + FNET_WIDTH
    o3 = o2 + Q_LORA
    o4 = o3 + KV_LORA
    o5 = o4 + QK_ROPE
    return jnp.split(z, [o1, o2, o3, o4, o5], axis=-1)


def _mla_q(cq, q_norm, w_q_up, rope):
    bn, L, _ = cq.shape
    q = (_rms_norm(cq, q_norm) @ w_q_up).reshape(bn, L, MLA_HEADS, QK_NOPE + QK_ROPE)
    if rope is not None:
        q = jnp.concatenate([q[..., :QK_NOPE], _axial_rope(q[..., QK_NOPE:], rope)], axis=-1)
    return q


def _mla_kv(ckv, kr, kv_norm, w_kv_up, rope):
    bn, L, _ = ckv.shape
    kv = (_rms_norm(ckv, kv_norm) @ w_kv_up).reshape(bn, L, MLA_HEADS, QK_NOPE + V_DIM)
    k_nope, v = kv[..., :QK_NOPE], kv[..., QK_NOPE:]
    kr = kr[:, :, None, :]
    if rope is not None:
        kr = _axial_rope(kr, rope)
    k = jnp.concatenate([k_nope, jnp.broadcast_to(kr, (bn, L, MLA_HEADS, QK_ROPE))], axis=-1)
    return k, v


def _block_attention(q, k, v):
    bn, L, H, dk = q.shape
    nb = L // Q_BLOCK
    scale = dk ** -0.5
    qb = q.reshape(bn, nb, Q_BLOCK, H, dk).transpose(1, 0, 2, 3, 4)

    def one(qi):
        s = jnp.einsum('bqhd,bkhd->bhqk', qi, k, preferred_element_type=jnp.float32) * scale
        p = jax.nn.softmax(s, axis=-1).astype(v.dtype)
        return jnp.einsum('bhqk,bkhd->bqhd', p, v)

    o = lax.map(one, qb)
    return o.transpose(1, 0, 2, 3, 4).reshape(bn, L, H * V_DIM)


def _cd_out(f_in, f_gate, attn, d_gate, fnet_w, w_out):
    yc = _fourier_mix(f_in, fnet_w) * jax.nn.silu(f_gate)
    yd = attn * jax.nn.silu(d_gate)
    return jnp.concatenate([yc, yd], axis=-1) @ w_out


def setup_inputs(seed: int = 0) -> dict:
    key = jax.random.key(seed)
    ks = jax.random.split(key, 32)

    def nrm(k, shape, scale):
        return jax.random.normal(k, shape, jnp.float32) * scale

    D = D_MODEL
    H = MLA_HEADS
    return {
        "x": nrm(ks[0], (BATCH, SEQ, D), 1.0),
        "c": nrm(ks[1], (BATCH, D), 1.0),
        "ctx": nrm(ks[2], (BATCH, CTX_LEN, D), 1.0),
        "c_ctx": nrm(ks[3], (D,), 1.0),
        "ab_w_mod": nrm(ks[4], (N_EVEN, D, 3 * D), 0.5 * D ** -0.5),
        "ab_b_mod": nrm(ks[5], (N_EVEN, 3 * D), 0.01),
        "ab_w_in": nrm(ks[6], (N_EVEN, D, AB_IN), D ** -0.5),
        "ab_pool_w": nrm(ks[7], (N_EVEN, POOL_GROUPS, POOL_GROUP_DIM, POOL_GROUP_DIM), POOL_GROUP_DIM ** -0.5),
        "ab_pool_scale": 1.0 + nrm(ks[8], (N_EVEN, POOL_WIDTH), 0.1),
        "ab_sgu_w": nrm(ks[9], (N_EVEN, SGU_HEADS, CHUNK, CHUNK), CHUNK ** -0.5),
        "ab_sgu_b": 1.0 + nrm(ks[10], (N_EVEN, SGU_HEADS, CHUNK), 0.01),
        "ab_w_out": nrm(ks[11], (N_EVEN, AB_MIX, D), BETA * AB_MIX ** -0.5),
        "ab_ln_g": 1.0 + nrm(ks[12], (N_EVEN, D), 0.1),
        "ab_ln_b": nrm(ks[13], (N_EVEN, D), 0.01),
        "cd_w_mod": nrm(ks[14], (N_ODD, D, 3 * D), 0.5 * D ** -0.5),
        "cd_b_mod": nrm(ks[15], (N_ODD, 3 * D), 0.01),
        "cd_w_in": nrm(ks[16], (N_ODD, D, CD_IN), D ** -0.5),
        "cd_fnet_w": nrm(ks[17], (N_ODD, FNET_WIDTH, FNET_WIDTH), FNET_WIDTH ** -0.5),
        "cd_q_norm": 1.0 + nrm(ks[18], (N_ODD, Q_LORA), 0.1),
        "cd_kv_norm": 1.0 + nrm(ks[19], (N_ODD, KV_LORA), 0.1),
        "cd_w_q_up": nrm(ks[20], (N_ODD, Q_LORA, H * (QK_NOPE + QK_ROPE)), Q_LORA ** -0.5),
        "cd_w_kv_up": nrm(ks[21], (N_ODD, KV_LORA, H * (QK_NOPE + V_DIM)), KV_LORA ** -0.5),
        "cd_w_out": nrm(ks[22], (N_ODD, CD_MIX, D), BETA * CD_MIX ** -0.5),
        "cd_ln_g": 1.0 + nrm(ks[23], (N_ODD, D), 0.1),
        "cd_ln_b": nrm(ks[24], (N_ODD, D), 0.01),
    }


def reference(x, c, ctx, c_ctx,
              ab_w_mod, ab_b_mod, ab_w_in, ab_pool_w, ab_pool_scale, ab_sgu_w, ab_sgu_b,
              ab_w_out, ab_ln_g, ab_ln_b,
              cd_w_mod, cd_b_mod, cd_w_in, cd_fnet_w, cd_q_norm, cd_kv_norm, cd_w_q_up,
              cd_w_kv_up, cd_w_out, cd_ln_g, cd_ln_b):
    L = x.shape[1]
    rope = _axial_tables(L, x.dtype)
    for i in range(DEPTH):
        last = i == DEPTH - 1
        j = i // 2
        if i % 2 == 0:
            sh, sc, gt = _adaln(c, ab_w_mod[j], ab_b_mod[j])
            h = x * (1.0 + sc[:, None]) + sh[:, None]
            y = _ab_mixer(h, ab_w_in[j], ab_pool_w[j], ab_pool_scale[j], ab_sgu_w[j], ab_sgu_b[j], ab_w_out[j])
            if not last:
                csh, csc, cgt = _adaln(c_ctx, ab_w_mod[j], ab_b_mod[j])
                hc = ctx * (1.0 + csc) + csh
                yc = _ab_mixer(hc, ab_w_in[j], ab_pool_w[j], ab_pool_scale[j], ab_sgu_w[j], ab_sgu_b[j], ab_w_out[j])
                ctx = _post_norm(ctx, yc, cgt, ab_ln_g[j], ab_ln_b[j])
            x = _post_norm(x, y, gt[:, None], ab_ln_g[j], ab_ln_b[j])
        else:
            csh, csc, cgt = _adaln(c_ctx, cd_w_mod[j], cd_b_mod[j])
            hc = ctx * (1.0 + csc) + csh
            fc_in, fc_gate, cq_c, ckv_c, kr_c, dc_gate = _split_cd(hc @ cd_w_in[j])
            k_ctx, v_ctx = _mla_kv(ckv_c, kr_c, cd_kv_norm[j], cd_w_kv_up[j], None)
            sh, sc, gt = _adaln(c, cd_w_mod[j], cd_b_mod[j])
            h = x * (1.0 + sc[:, None]) + sh[:, None]
            f_in, f_gate, cq, ckv, kr, d_gate = _split_cd(h @ cd_w_in[j])
            k_lat, v_lat = _mla_kv(ckv, kr, cd_kv_norm[j], cd_w_kv_up[j], rope)
            q = _mla_q(cq, cd_q_norm[j], cd_w_q_up[j], rope)
            attn = _block_attention(q, jnp.concatenate([k_ctx, k_lat], axis=1),
                                    jnp.concatenate([v_ctx, v_lat], axis=1))
            y = _cd_out(f_in, f_gate, attn, d_gate, cd_fnet_w[j], cd_w_out[j])
            if not last:
                qc = _mla_q(cq_c, cd_q_norm[j], cd_w_q_up[j], None)
                attn_c = _block_attention(qc, k_ctx, v_ctx)
                yc = _cd_out(fc_in, fc_gate, attn_c, dc_gate, cd_fnet_w[j], cd_w_out[j])
                ctx = _post_norm(ctx, yc, cgt, cd_ln_g[j], cd_ln_b[j])
            x = _post_norm(x, y, gt[:, None], cd_ln_g[j], cd_ln_b[j])
    return x
```

```cpp
#include <hip/hip_runtime.h>
#include <hip/hip_cooperative_groups.h>
namespace cg = cooperative_groups;
#include <stdint.h>
#include <cstdio>

typedef unsigned short bf16_t;
typedef _Float16 h16_t;

#define DI __device__ __forceinline__
DI float bf2f(bf16_t v) { return __uint_as_float(((unsigned)v) << 16); }
DI bf16_t f2bf(float f) { unsigned u = __float_as_uint(f); u += 0x7fffu + ((u >> 16) & 1u); return (bf16_t)(u >> 16); }
DI float silu(float x) { return x / (1.f + expf(-x)); }
DI float wave_sum(float v) {
#pragma unroll
    for (int o = 1; o < 64; o <<= 1) v += __shfl_xor(v, o);
    return v;
}

constexpr int NB = 32, SEQ = 2048, DM = 1024, CTXL = 256;
constexpr int NLAT = NB * SEQ;
constexpr int NCTX = NB * CTXL;
constexpr int NROW = NLAT + NCTX;
constexpr int ABIN = 2560, CDIN = 1952, Z1LD = 2048;
#define Z0OFF(ss, row) ((((size_t)(ss)) * NROW + (size_t)(row)) * 128)
constexpr float EPS = 1e-6f;
constexpr float ALPHA = 1.41421356237309515f;
constexpr float QSCALE = 0.10206207261596577f * 1.4426950408889634f;

constexpr size_t MiB = 1u << 20;
constexpr size_t OFF_A = 0;
constexpr size_t OFF_KR = 448 * MiB;
constexpr size_t OFF_R0C = 432 * MiB;
constexpr size_t OFF_B = 144 * MiB;
constexpr size_t OFF_ZC1 = 400 * MiB;
constexpr size_t OFF_KV = 504 * MiB;
constexpr size_t OFF_T1 = 648 * MiB;
constexpr size_t OFF_MIX1 = 792 * MiB;
constexpr size_t OFF_FT = 792 * MiB;
constexpr size_t OFF_DFT = 920 * MiB;
constexpr size_t OFF_W = 936 * MiB;
constexpr size_t OFF_WIN0 = OFF_W, OFF_WOUT0 = OFF_W + 5 * MiB, OFF_WIN1 = OFF_W + 7 * MiB, OFF_WOUT1 = OFF_W + 11 * MiB, OFF_WFN = OFF_W + 13 * MiB, OFF_WQ = OFF_W + 14 * MiB, OFF_WKV = OFF_W + 15 * MiB, OFF_WPOOL = OFF_W + 15 * MiB + 512 * 1024, OFF_WSGU = OFF_WPOOL + 128 * 1024;
constexpr size_t OFF_SMALL = 952 * MiB;
constexpr size_t OFF_MOD0 = OFF_SMALL, OFF_MOD1 = OFF_SMALL + 512 * 1024, OFF_COS = OFF_SMALL + 1024 * 1024, OFF_SIN = OFF_COS + 8192,
                 OFF_RQ = OFF_SMALL + 2 * MiB, OFF_RKV = OFF_SMALL + 3 * MiB, OFF_ROPE = OFF_SMALL + 4608 * 1024, OFF_CTL = OFF_SMALL + 5 * MiB, OFF_ST1 = OFF_SMALL + 6 * MiB;
constexpr size_t CTL_BYTES = 64 * 1024;

struct RowInfo { int b, t, L, modrow, base; };
DI RowInfo rowinfo(int row) {
    RowInfo r;
    if (row < NLAT) { r.b = row >> 11; r.t = row & 2047; r.L = SEQ; r.modrow = r.b; r.base = r.b * SEQ; }
    else { int rc = row - NLAT; r.b = rc >> 8; r.t = rc & 255; r.L = CTXL; r.modrow = 32; r.base = NLAT + r.b * CTXL; }
    return r;
}


namespace pg8 {
#define PG8_LAS __attribute__((address_space(3)))
typedef unsigned short bf16_t;
typedef short bf16x8 __attribute__((ext_vector_type(8)));
typedef float f32x4 __attribute__((ext_vector_type(4)));
typedef unsigned u32x4 __attribute__((ext_vector_type(4)));
constexpr int BM = 256, BK = 64, HALF = 128, HTB = HALF * BK * 2  , STAGE_BYTES = 8 * HTB, NXCD = 8, WGM = 8;

__host__ __device__ __forceinline__ int lds_byte(int r, int c) { const int st = (r >> 4) * 2 + (c >> 5), rr = r & 15, cc = c & 31, ob = rr * 64 + cc * 2; return st * 1024 + (ob ^ (((ob >> 9) & 1) << 5)); }
__host__ __device__ __forceinline__ void stage_rc(int b, int& R, int& C) { const int st = b / 1024, sb = b % 1024, swz = sb ^ (((sb >> 9) & 1) << 5); R = (st >> 1) * 16 + swz / 64; C = (st & 1) * 32 + (swz % 64) / 2; }
__host__ __device__ __forceinline__ int perm32(int rho) { const int n = rho >> 4, i = rho & 15; return 8 * (i >> 2) + 4 * n + (i & 3); }

struct Unit { int pm, pn; };
struct Gemm { const bf16_t* A; const bf16_t* Bt; int M, N, K, lda, ldb, pad; };

struct StaticOrder {
    int nM, nN, nwg, G, c;
    __host__ __device__ void init(int M, int N, int G_, int c_) { nM = M / BM; nN = N / BM; nwg = nM * nN; G = G_; c = c_; }
    __host__ __device__ bool next(int i, Unit& u) const {
        const long L = (long)i * G + c; if (L >= nwg) return false;
        int wgid = (int)L; { const int q = nwg / NXCD, r = nwg % NXCD, xcd = wgid % NXCD, off = wgid / NXCD; wgid = (xcd < r ? xcd * (q + 1) : r * (q + 1) + (xcd - r) * q) + off; }
        const int nig = WGM * nN, gid = wgid / nig, fm = gid * WGM, gsz = (nM - fm) < WGM ? (nM - fm) : WGM;
        u.pm = fm + ((wgid % nig) % gsz); u.pn = (wgid % nig) / gsz; return true;
    }
    __device__ __forceinline__ void a_ready(const Unit&) const {}
    __device__ __forceinline__ void done(const Unit&) const {}
    __device__ __forceinline__ size_t offA(const Unit& u, size_t ts) const { return (size_t)u.pm * ts; }
    __device__ __forceinline__ size_t offB(const Unit& u, size_t ts) const { return (size_t)u.pn * ts; }
    DI size_t halfB(size_t h) const { return h; }
};

__device__ __forceinline__ unsigned cvt_pk_bf16(float lo, float hi) { unsigned r; asm volatile("v_cvt_pk_bf16_f32 %0, %1, %2" : "=v"(r) : "v"(lo), "v"(hi)); return r; }
typedef float f32x2 __attribute__((ext_vector_type(2)));
__device__ __forceinline__ f32x2 gelu_pk(f32x2 v) {
    const f32x2 av = __builtin_elementwise_abs(v), d = av * 0.2316418882f + 1.0f;
    f32x2 t; t.x = __builtin_amdgcn_rcpf(d.x); t.y = __builtin_amdgcn_rcpf(d.y);
    f32x2 q = t * 0.5307027145f + (-0.7265760135f); q = q * t + 0.7107068705f; q = q * t + (-0.142248368f); q = q * t + 0.127414796f; q = q * t;
    const f32x2 s = (v * v) * (-0.72134752044f);
    f32x2 e; e.x = __builtin_amdgcn_exp2f(s.x); e.y = __builtin_amdgcn_exp2f(s.y);
    const f32x2 m = v * (q * e), r = v - m;
    f32x2 o; o.x = v.x < 0.f ? m.x : r.x; o.y = v.y < 0.f ? m.y : r.y; return o;
}

template <int ACT  > struct EpiBf16 {
    static constexpr bool PERM = true, AFTER_DRAIN = false; static_assert(ACT == 0 || ACT == 1, "EpiBf16: ACT is 0 (none) or 1 (gelu_pk)");
    bf16_t* O; int ldc; const float* bias; int split_cols; size_t split_stride; float scale0;
    __device__ __forceinline__ void operator()(const f32x4 (&acc)[2][2][4][2], const Unit& u, int wr, int wc, int fr, int fq) const {
        const int row0 = u.pm * BM + wr * 64 + fr; int colt = u.pn * BM; bf16_t* base = O;
        float sc = 1.f; if (split_cols) { const int t = colt / split_cols; base += (size_t)t * split_stride; colt -= t * split_cols; if (t == 0) sc = scale0; }
        const int col0 = colt + wc * 32 + 8 * fq, bcol0 = u.pn * BM + wc * 32 + 8 * fq;
        f32x4 bv[2][2];
#pragma unroll
        for (int bj = 0; bj < 2; ++bj)
#pragma unroll
            for (int n = 0; n < 2; ++n) bv[bj][n] = bias ? *(const f32x4*)(bias + bcol0 + bj * HALF + 4 * n) : (f32x4){0.f, 0.f, 0.f, 0.f};
#pragma unroll
        for (int ai = 0; ai < 2; ++ai)
#pragma unroll
            for (int m = 0; m < 4; ++m) { bf16_t* rowp = base + (size_t)(row0 + ai * HALF + m * 16) * ldc + col0;
#pragma unroll
                for (int bj = 0; bj < 2; ++bj) { f32x4 v0 = acc[ai][bj][m][0] + bv[bj][0], v1 = acc[ai][bj][m][1] + bv[bj][1];
                    if (ACT == 1) { f32x2 a = gelu_pk((f32x2){v0[0], v0[1]}), b = gelu_pk((f32x2){v0[2], v0[3]}), c = gelu_pk((f32x2){v1[0], v1[1]}), d = gelu_pk((f32x2){v1[2], v1[3]});
                        v0 = (f32x4){a.x, a.y, b.x, b.y}; v1 = (f32x4){c.x, c.y, d.x, d.y}; }
                    v0 = v0 * sc; v1 = v1 * sc; u32x4 w; w.x = cvt_pk_bf16(v0[0], v0[1]); w.y = cvt_pk_bf16(v0[2], v0[3]); w.z = cvt_pk_bf16(v1[0], v1[1]); w.w = cvt_pk_bf16(v1[2], v1[3]);
                    *(u32x4*)(rowp + bj * HALF) = w; } }
    }
};

template <class Epi, class Sched, bool ALIGN_EPI = false, bool SP2 = false>
__device__ __forceinline__ void gemm_phase(PG8_LAS unsigned char* lds, const Gemm g, const Sched& S, const Epi& E) {
    int tid_ = threadIdx.x; asm volatile("" : "+v"(tid_));
    const int tid = tid_, wid = __builtin_amdgcn_readfirstlane(tid >> 6), lane = tid & 63, wr = wid >> 2, wc = wid & 3, fr = lane & 15, fq = lane >> 4;
    int K_ = g.K; asm volatile("" : "+s"(K_));
    const int K = K_, nt = K / BK;
    unsigned voffA[2], voffB[2];
#pragma unroll
    for (int i = 0; i < 2; ++i) { int R, C; stage_rc(tid * 16 + i * 8192, R, C); const int Rb = Epi::PERM ? ((R & ~31) + perm32(R & 31)) : R;
        voffA[i] = (unsigned)(R * g.lda + C) * 2u; voffB[i] = (unsigned)(Rb * g.ldb + C) * 2u; }
    const size_t kstep = (size_t)(BK * 2);
    const size_t hstepA = (size_t)HALF * g.lda * 2, hB0 = (size_t)HALF * g.ldb * 2, hstepB = S.halfB(hB0);
    const size_t tstepA = 2 * hstepA, tstepB = 2 * hB0;
    const unsigned ldsw = (unsigned)wid * 1024u;
    const int aoff = lds_byte(wr * 64 + fr, fq * 8), boff = lds_byte(wc * 32 + fr, fq * 8);
#define PG8_SA(b, h) (((b) * 2 + (h)) * HTB)
#define PG8_SB(b, h) ((4 + (b) * 2 + (h)) * HTB)
#define PG8_STAGE(bufoff, gbase, voff) do { _Pragma("unroll") for (int _i = 0; _i < 2; ++_i) \
        __builtin_amdgcn_global_load_lds((const unsigned*)((const char*)(gbase) + (voff)[_i]), (PG8_LAS unsigned*)(lds + (bufoff) + ldsw + _i * 8192), 16, 0, 0); } while (0)
#define PG8_LDA(dst, b, h) do { _Pragma("unroll") for (int m = 0; m < 4; ++m) _Pragma("unroll") for (int k = 0; k < 2; ++k) dst[m][k] = *(const PG8_LAS bf16x8*)(lds + PG8_SA(b, h) + aoff + m * 2048 + k * 1024); } while (0)
#define PG8_LDB(dst, b, h) do { _Pragma("unroll") for (int n = 0; n < 2; ++n) _Pragma("unroll") for (int k = 0; k < 2; ++k) dst[n][k] = *(const PG8_LAS bf16x8*)(lds + PG8_SB(b, h) + boff + n * 2048 + k * 1024); } while (0)
#define PG8_MMA(ai, bj, At, Bt) do { __builtin_amdgcn_s_setprio(1); _Pragma("unroll") for (int m = 0; m < 4; ++m) _Pragma("unroll") for (int n = 0; n < 2; ++n) _Pragma("unroll") for (int k = 0; k < 2; ++k) \
        acc[ai][bj][m][n] = __builtin_amdgcn_mfma_f32_16x16x32_bf16(Bt[n][k], At[m][k], acc[ai][bj][m][n], 0, 0, 0); __builtin_amdgcn_s_setprio(0); } while (0)
#define PG8_WAIT_V(n) asm volatile("s_waitcnt vmcnt(" #n ")" ::: "memory")
#define PG8_WAIT_L(n) asm volatile("s_waitcnt lgkmcnt(" #n ")" ::: "memory")
#define PG8_BAR __builtin_amdgcn_s_barrier()
#define PG8_SCHED __builtin_amdgcn_sched_barrier(0)
    Unit cur, nxt; int ui = 0;
    if (!S.next(0, cur)) return;
    f32x4 acc[2][2][4][2];
#pragma unroll
    for (int a = 0; a < 2; ++a)
#pragma unroll
        for (int b = 0; b < 2; ++b)
#pragma unroll
            for (int m = 0; m < 4; ++m)
#pragma unroll
                for (int n = 0; n < 2; ++n) acc[a][b][m][n] = (f32x4){0.f, 0.f, 0.f, 0.f};
    bf16x8 At[4][2], B0[2][2], B1[2][2];
    const char* cA = (const char*)g.A + S.offA(cur, tstepA); const char* cB = (const char*)g.Bt + S.offB(cur, tstepB);
    S.a_ready(cur);
    if constexpr (SP2) {
        PG8_STAGE(PG8_SB(0, 0), cB, voffB); PG8_STAGE(PG8_SB(0, 1), cB + hstepB, voffB); PG8_STAGE(PG8_SA(0, 0), cA, voffA); PG8_STAGE(PG8_SA(0, 1), cA + hstepA, voffA);
        if (wr == 1) PG8_BAR;
        PG8_WAIT_V(2); PG8_BAR;
        PG8_STAGE(PG8_SB(1, 0), cB + kstep, voffB); PG8_STAGE(PG8_SA(1, 0), cA + kstep, voffA); PG8_STAGE(PG8_SB(1, 1), cB + hstepB + kstep, voffB);
        PG8_WAIT_V(6); PG8_BAR;
    } else {
        PG8_STAGE(PG8_SB(0, 0), cB, voffB); PG8_STAGE(PG8_SA(0, 0), cA, voffA); PG8_STAGE(PG8_SB(0, 1), cB + hstepB, voffB); PG8_STAGE(PG8_SA(0, 1), cA + hstepA, voffA);
        if (wr == 1) PG8_BAR;
        PG8_WAIT_V(4); PG8_BAR;
        PG8_STAGE(PG8_SB(1, 0), cB + kstep, voffB); PG8_STAGE(PG8_SA(1, 0), cA + kstep, voffA); PG8_STAGE(PG8_SB(1, 1), cB + hstepB + kstep, voffB);
        PG8_WAIT_V(6); PG8_BAR;
    }
    for (;;) {
        const bool has_next = S.next(ui + 1, nxt);
        const char* nA = has_next ? (const char*)g.A + S.offA(nxt, tstepA) : cA; const char* nB = has_next ? (const char*)g.Bt + S.offB(nxt, tstepB) : cB;
        for (int t = 0; t < nt; t += 2) {
            const bool last = (t == nt - 2);
            const char* a1 = cA + (size_t)(t + 1) * kstep;
            const char* a2 = last ? nA : cA + (size_t)(t + 2) * kstep; const char* b2 = last ? nB : cB + (size_t)(t + 2) * kstep;
            const char* a3 = a2 + kstep; const char* b3 = b2 + kstep;
            if (last && has_next) S.a_ready(nxt);
            if constexpr (SP2) {
            PG8_LDB(B0, 0, 0); PG8_LDB(B1, 0, 1); PG8_SCHED; PG8_LDA(At, 0, 0); PG8_STAGE(PG8_SA(1, 1), a1 + hstepA, voffA);
            PG8_WAIT_V(8); PG8_WAIT_L(0); PG8_BAR; PG8_MMA(0, 0, At, B0); PG8_MMA(0, 1, At, B1); PG8_BAR; PG8_SCHED;
            PG8_LDA(At, 0, 1); PG8_STAGE(PG8_SB(0, 0), b2, voffB); PG8_STAGE(PG8_SB(0, 1), b2 + hstepB, voffB); PG8_STAGE(PG8_SA(0, 0), a2, voffA);
            PG8_WAIT_V(8); PG8_WAIT_L(0); PG8_BAR; PG8_MMA(1, 0, At, B0); PG8_MMA(1, 1, At, B1); PG8_BAR; PG8_SCHED;
            PG8_LDB(B0, 1, 0); PG8_LDB(B1, 1, 1); PG8_SCHED; PG8_LDA(At, 1, 0); PG8_STAGE(PG8_SA(0, 1), a2 + hstepA, voffA);
            PG8_WAIT_V(8); PG8_WAIT_L(0); PG8_BAR; PG8_MMA(0, 0, At, B0); PG8_MMA(0, 1, At, B1); PG8_BAR; PG8_SCHED;
            PG8_LDA(At, 1, 1); PG8_STAGE(PG8_SB(1, 0), b3, voffB); PG8_STAGE(PG8_SB(1, 1), b3 + hstepB, voffB); PG8_STAGE(PG8_SA(1, 0), a3, voffA);
            PG8_WAIT_V(8); PG8_WAIT_L(0); PG8_BAR; PG8_MMA(1, 0, At, B0); PG8_MMA(1, 1, At, B1); PG8_BAR; PG8_SCHED;
            } else {
            PG8_LDB(B0, 0, 0); PG8_SCHED; PG8_LDA(At, 0, 0); PG8_STAGE(PG8_SA(1, 1), a1 + hstepA, voffA);
            PG8_WAIT_L(8); PG8_BAR; PG8_WAIT_L(0); PG8_MMA(0, 0, At, B0); PG8_BAR; PG8_SCHED;
            PG8_LDB(B1, 0, 1); PG8_STAGE(PG8_SB(0, 0), b2, voffB);
            PG8_BAR; PG8_WAIT_L(0); PG8_MMA(0, 1, At, B1); PG8_BAR;
            PG8_LDA(At, 0, 1); PG8_STAGE(PG8_SA(0, 0), a2, voffA);
            PG8_BAR; PG8_WAIT_L(0); PG8_MMA(1, 0, At, B0); PG8_BAR; PG8_SCHED;
            PG8_STAGE(PG8_SB(0, 1), b2 + hstepB, voffB);
            PG8_WAIT_V(6); PG8_BAR; PG8_MMA(1, 1, At, B1); PG8_BAR;
            PG8_LDB(B0, 1, 0); PG8_SCHED; PG8_LDA(At, 1, 0); PG8_STAGE(PG8_SA(0, 1), a2 + hstepA, voffA);
            PG8_WAIT_L(8); PG8_BAR; PG8_WAIT_L(0); PG8_MMA(0, 0, At, B0); PG8_BAR; PG8_SCHED;
            PG8_LDB(B1, 1, 1); PG8_STAGE(PG8_SB(1, 0), b3, voffB);
            PG8_BAR; PG8_WAIT_L(0); PG8_MMA(0, 1, At, B1); PG8_BAR;
            PG8_LDA(At, 1, 1); PG8_STAGE(PG8_SA(1, 0), a3, voffA);
            PG8_BAR; PG8_WAIT_L(0); PG8_MMA(1, 0, At, B0); PG8_BAR; PG8_SCHED;
            PG8_STAGE(PG8_SB(1, 1), b3 + hstepB, voffB);
            PG8_WAIT_V(6); PG8_BAR; PG8_MMA(1, 1, At, B1); PG8_BAR;
            }
        }
        if constexpr (ALIGN_EPI) { if (wr == 0) PG8_BAR; }
        if constexpr (!Epi::AFTER_DRAIN) { E(acc, cur, wr, wc, fr, fq); S.done(cur); }
        if (!has_next) break;
#pragma unroll
        for (int a = 0; a < 2; ++a)
#pragma unroll
            for (int b = 0; b < 2; ++b)
#pragma unroll
                for (int m = 0; m < 4; ++m)
#pragma unroll
                    for (int n = 0; n < 2; ++n) acc[a][b][m][n] = (f32x4){0.f, 0.f, 0.f, 0.f};
        cur = nxt; cA = nA; cB = nB; ++ui;
        if constexpr (ALIGN_EPI) { if (wr == 1) PG8_BAR; }
    }
    PG8_WAIT_V(0);
    if constexpr (!ALIGN_EPI) { if (wr == 0) PG8_BAR; }
    PG8_BAR;
    if constexpr (Epi::AFTER_DRAIN) { E.fused(acc, cur, wr, wc, fr, fq, lds, wid, lane); S.done(cur); }
#undef PG8_SA
#undef PG8_SB
#undef PG8_STAGE
#undef PG8_LDA
#undef PG8_LDB
#undef PG8_MMA
#undef PG8_WAIT_V
#undef PG8_WAIT_L
#undef PG8_BAR
#undef PG8_SCHED
}
}

namespace pg8 {
typedef _Float16 h16x2 __attribute__((ext_vector_type(2)));
DI unsigned pk_h2(float a, float b) { h16x2 t = {(_Float16)a, (_Float16)b}; return __builtin_bit_cast(unsigned, t); }
DI float silu_fast(float x) { return x * __builtin_amdgcn_rcpf(1.f + __builtin_amdgcn_exp2f(-1.4426950408889634f * x)); }

DI void rope_cs4(float pos, int n, f32x4& cs, f32x4& sn) {
    constexpr float F[8] = {0.15915494309189535f, 0.050329212104487035f, 0.015915494309189534f, 0.0050329212104487035f, 0.0015915494309189534f, 0.00050329212104487035f, 0.00015915494309189535f, 0.000050329212104487035f};
#pragma unroll
    for (int i = 0; i < 4; ++i) { const float r = pos * F[4 * n + i]; cs[i] = __builtin_amdgcn_cosf(r); sn[i] = __builtin_amdgcn_sinf(r); }
}
struct EpiZ0 {
    static constexpr bool PERM = true, AFTER_DRAIN = false;
    bf16_t* Z0;
    DI void operator()(const f32x4 (&acc)[2][2][4][2], const Unit& u, int wr, int wc, int fr, int fq) const {
        asm volatile("" : "+v"(fr), "+v"(fq));
        const int row0 = u.pm * BM + wr * 64 + fr, cw = wc * 32 + 8 * fq;
        const bool ug = u.pn >= 4 && u.pn < 8, sg = u.pn == 2 || u.pn == 3;
        const int colb = u.pn < 4 ? u.pn * BM : ug ? 1024 + 128 * (u.pn - 4) : 1536 + BM * (u.pn - 8);
#pragma unroll
        for (int ai = 0; ai < 2; ++ai)
#pragma unroll
            for (int m = 0; m < 4; ++m) {
                bf16_t* orow = Z0 + Z0OFF(colb >> 7, row0 + ai * HALF + m * 16) + cw;
                if (ug) {
                    const f32x4 u0 = acc[ai][0][m][0], u1 = acc[ai][0][m][1], g0 = acc[ai][1][m][0], g1 = acc[ai][1][m][1];
                    u32x4 w; w.x = cvt_pk_bf16(u0[0] * silu_fast(g0[0]), u0[1] * silu_fast(g0[1])); w.y = cvt_pk_bf16(u0[2] * silu_fast(g0[2]), u0[3] * silu_fast(g0[3]));
                    w.z = cvt_pk_bf16(u1[0] * silu_fast(g1[0]), u1[1] * silu_fast(g1[1])); w.w = cvt_pk_bf16(u1[2] * silu_fast(g1[2]), u1[3] * silu_fast(g1[3]));
                    *(u32x4*)orow = w;
                } else {
#pragma unroll
                    for (int bj = 0; bj < 2; ++bj) { f32x4 v0 = acc[ai][bj][m][0], v1 = acc[ai][bj][m][1];
                        if (sg) {
#pragma unroll
                            for (int i = 0; i < 4; ++i) { v0[i] = silu_fast(v0[i]); v1[i] = silu_fast(v1[i]); } }
                        u32x4 w; w.x = cvt_pk_bf16(v0[0], v0[1]); w.y = cvt_pk_bf16(v0[2], v0[3]); w.z = cvt_pk_bf16(v1[0], v1[1]); w.w = cvt_pk_bf16(v1[2], v1[3]);
                        *(u32x4*)(orow + (size_t)bj * NROW * 128) = w; }
                }
            }
    }
};
struct EpiOut0 {
    static constexpr bool PERM = true, AFTER_DRAIN = false;
    const float* x; const float* ctx; const float* MOD0; h16_t* R0; h16_t* R0C;
    DI void operator()(const f32x4 (&acc)[2][2][4][2], const Unit& u, int wr, int wc, int fr, int fq) const {
        asm volatile("" : "+v"(fr), "+v"(fq));
        const int row0 = u.pm * BM + wr * 64 + fr, col0 = u.pn * BM + wc * 32 + 8 * fq;
        const bool lat = u.pm < 256;
        const float* gate = MOD0 + (lat ? (u.pm >> 3) : 32) * 3072 + 2048 + col0;
        const float* xb = (lat ? x + (size_t)row0 * DM : ctx + (size_t)(row0 - NLAT) * DM) + col0;
        h16_t* ob = (lat ? R0 + (size_t)row0 * 2048 : R0C + (size_t)(row0 - NLAT) * DM) + col0; const size_t os = lat ? 2048 : DM;
        f32x4 gv[2][2];
#pragma unroll
        for (int bj = 0; bj < 2; ++bj)
#pragma unroll
            for (int n = 0; n < 2; ++n) gv[bj][n] = *(const f32x4*)(gate + bj * HALF + 4 * n);
        f32x4 xa[2][2][2], xc[2][2][2];
#define EO0_LOAD(X, bt) do { _Pragma("unroll") for (int mm = 0; mm < 2; ++mm) _Pragma("unroll") for (int bj = 0; bj < 2; ++bj) _Pragma("unroll") for (int n = 0; n < 2; ++n) \
            X[mm][bj][n] = *(const f32x4*)(xb + (size_t)(((bt) >> 1) * HALF + (((bt) & 1) * 2 + mm) * 16) * DM + bj * HALF + 4 * n); } while (0)
#define EO0_STORE(X, bt) do { _Pragma("unroll") for (int mm = 0; mm < 2; ++mm) _Pragma("unroll") for (int bj = 0; bj < 2; ++bj) { const int ai_ = (bt) >> 1, m_ = ((bt) & 1) * 2 + mm; \
            const f32x4 v0 = X[mm][bj][0] * ALPHA + gv[bj][0] * acc[ai_][bj][m_][0], v1 = X[mm][bj][1] * ALPHA + gv[bj][1] * acc[ai_][bj][m_][1]; \
            u32x4 w; w.x = pk_h2(v0[0], v0[1]); w.y = pk_h2(v0[2], v0[3]); w.z = pk_h2(v1[0], v1[1]); w.w = pk_h2(v1[2], v1[3]); \
            *(u32x4*)(ob + (size_t)(ai_ * HALF + m_ * 16) * os + bj * HALF) = w; } } while (0)
        EO0_LOAD(xa, 0); EO0_LOAD(xc, 1);
        EO0_STORE(xa, 0); EO0_LOAD(xa, 2);
        EO0_STORE(xc, 1); EO0_LOAD(xc, 3);
        EO0_STORE(xa, 2); EO0_STORE(xc, 3);
#undef EO0_LOAD
#undef EO0_STORE
    }
};
struct EpiRowScale {
    static constexpr bool PERM = true, AFTER_DRAIN = false;
    bf16_t* O; const float* rs; int ldc; int pad;
    DI void operator()(const f32x4 (&acc)[2][2][4][2], const Unit& u, int wr, int wc, int fr, int fq) const {
        asm volatile("" : "+v"(fr), "+v"(fq));
        const int row0 = u.pm * BM + wr * 64 + fr, col0 = u.pn * BM + wc * 32 + 8 * fq;
        f32x4 pq[2][4];
#pragma unroll
        for (int ai = 0; ai < 2; ++ai)
#pragma unroll
            for (int m = 0; m < 4; ++m) pq[ai][m] = *(const f32x4*)(rs + (size_t)(row0 + ai * HALF + m * 16) * 4);
#pragma unroll
        for (int ai = 0; ai < 2; ++ai)
#pragma unroll
            for (int m = 0; m < 4; ++m) {
                const int row = row0 + ai * HALF + m * 16; const f32x4 p4 = pq[ai][m];
                const float sc = __builtin_amdgcn_rsqf(((p4[0] + p4[1]) + (p4[2] + p4[3])) * (1.f / 128.f) + EPS);
                bf16_t* orow = O + (size_t)row * ldc + col0;
#pragma unroll
                for (int bj = 0; bj < 2; ++bj) { const f32x4 v0 = acc[ai][bj][m][0] * sc, v1 = acc[ai][bj][m][1] * sc;
                    u32x4 w; w.x = cvt_pk_bf16(v0[0], v0[1]); w.y = cvt_pk_bf16(v0[2], v0[3]); w.z = cvt_pk_bf16(v1[0], v1[1]); w.w = cvt_pk_bf16(v1[2], v1[3]);
                    *(u32x4*)(orow + bj * HALF) = w; }
            }
    }
};
struct EpiQ {
    static constexpr bool PERM = true, AFTER_DRAIN = false;
    bf16_t* Q; const float* RQ; const float* ROPE;
    DI void operator()(const f32x4 (&acc)[2][2][4][2], const Unit& u, int wr, int wc, int fr, int fq) const {
        asm volatile("" : "+v"(fr), "+v"(fq));
        const int row0 = u.pm * BM + wr * 64 + fr, col0 = u.pn * BM + wc * 32 + 8 * fq;
        const bool odd = (fq & 1) != 0;
        float scv[2][4];
        {   f32x4 pqa[2][4];
#pragma unroll
            for (int ai = 0; ai < 2; ++ai)
#pragma unroll
                for (int m = 0; m < 4; ++m) pqa[ai][m] = *(const f32x4*)(RQ + (size_t)(row0 + ai * HALF + m * 16) * 4);
#pragma unroll
            for (int ai = 0; ai < 2; ++ai)
#pragma unroll
                for (int m = 0; m < 4; ++m) scv[ai][m] = __builtin_amdgcn_rsqf(((pqa[ai][m][0] + pqa[ai][m][1]) + (pqa[ai][m][2] + pqa[ai][m][3])) * (1.f / 256.f) + EPS) * QSCALE; }
#pragma unroll
        for (int ai = 0; ai < 2; ++ai)
#pragma unroll
            for (int m = 0; m < 4; ++m) {
                const int row = row0 + ai * HALF + m * 16; const float sc = scv[ai][m]; const int t = row & 2047;
                const float pos = (float)(fq < 2 ? (t >> 6) : (t & 63));
                bf16_t* orow = Q + (size_t)row * 768 + col0;
#pragma unroll
                for (int bj = 0; bj < 2; ++bj) {
                    f32x4 v[2] = {acc[ai][bj][m][0] * sc, acc[ai][bj][m][1] * sc};
                    const int g32 = 8 * u.pn + 4 * bj + wc;
                    if (g32 % 3 == 2) {
#pragma unroll
                        for (int n = 0; n < 2; ++n) {
                            f32x4 cs, sn; rope_cs4(pos, n, cs, sn);
                            f32x4 oth;
#pragma unroll
                            for (int i = 0; i < 4; ++i) oth[i] = __shfl_xor(v[n][i], 16);
                            v[n] = odd ? (oth * sn + v[n] * cs) : (v[n] * cs - oth * sn);
                        }
                    }
                    u32x4 w; w.x = cvt_pk_bf16(v[0][0], v[0][1]); w.y = cvt_pk_bf16(v[0][2], v[0][3]); w.z = cvt_pk_bf16(v[1][0], v[1][1]); w.w = cvt_pk_bf16(v[1][2], v[1][3]);
                    *(u32x4*)(orow + bj * HALF) = w; }
                asm volatile("" ::: "memory");
            }
    }
};
struct EpiYc {
    static constexpr bool PERM = true, AFTER_DRAIN = false;
    const bf16_t* Z1; bf16_t* MIX1;
    DI void operator()(const f32x4 (&acc)[2][2][4][2], const Unit& u, int wr, int wc, int fr, int fq) const {
        asm volatile("" : "+v"(fr), "+v"(fq));
        const int b = u.pm >> 2, k0 = (u.pm & 3) * BM + wr * 64 + fr, col0 = (u.pn & 1) * BM + wc * 32 + 8 * fq;
        const bool mir = u.pn >= 2;
        u32x4 ga[4][2], gc[4][2];
#define EYC_ROW(ai_, m_) ((size_t)(mir ? b * 2048 + 2048 - (k0 + (ai_) * HALF + (m_) * 16) : b * 2048 + (k0 + (ai_) * HALF + (m_) * 16)))
#define EYC_LOAD(X, ai_) do { _Pragma("unroll") for (int m = 0; m < 4; ++m) _Pragma("unroll") for (int bj = 0; bj < 2; ++bj) X[m][bj] = *(const u32x4*)(Z1 + EYC_ROW(ai_, m) * Z1LD + 512 + col0 + bj * HALF); } while (0)
#define EYC_STORE(X, ai_) do { _Pragma("unroll") for (int m = 0; m < 4; ++m) _Pragma("unroll") for (int bj = 0; bj < 2; ++bj) { const u32x4 gw = X[m][bj]; float gt[8]; \
            _Pragma("unroll") for (int i = 0; i < 4; ++i) { gt[2 * i] = __uint_as_float(gw[i] << 16); gt[2 * i + 1] = __uint_as_float(gw[i] & 0xffff0000u); } \
            const f32x4 a0 = acc[ai_][bj][m][0], a1 = acc[ai_][bj][m][1]; \
            u32x4 w; w.x = cvt_pk_bf16(a0[0] * silu_fast(gt[0]), a0[1] * silu_fast(gt[1])); w.y = cvt_pk_bf16(a0[2] * silu_fast(gt[2]), a0[3] * silu_fast(gt[3])); \
            w.z = cvt_pk_bf16(a1[0] * silu_fast(gt[4]), a1[1] * silu_fast(gt[5])); w.w = cvt_pk_bf16(a1[2] * silu_fast(gt[6]), a1[3] * silu_fast(gt[7])); \
            if (!(mir && (k0 + (ai_) * HALF + m * 16) == 0)) *(u32x4*)(MIX1 + EYC_ROW(ai_, m) * DM + col0 + bj * HALF) = w; } } while (0)
        EYC_LOAD(ga, 0); EYC_LOAD(gc, 1);
        EYC_STORE(ga, 0); EYC_STORE(gc, 1);
#undef EYC_ROW
#undef EYC_LOAD
#undef EYC_STORE
    }
};
struct YcOrder {
    int G, c;
    DI bool next(int i, Unit& u) const { const int L = i * G + c; if (L >= 512) return false; u.pm = L >> 2; u.pn = L & 3; return true; }
    DI void a_ready(const Unit&) const {}
    DI void done(const Unit&) const {}
    DI size_t offA(const Unit& u, size_t) const { return ((size_t)((u.pm >> 2) * 2048 + (u.pm & 3) * 256) * DM) * 2; }
    DI size_t offB(const Unit& u, size_t ts) const { return (size_t)u.pn * ts; }
    DI size_t halfB(size_t h) const { return h; }
};
struct Z1Order {
    int G, c, nctx;
    DI void init(int G_, int c_, int nctx_) { G = G_; c = c_; nctx = nctx_; }
    DI bool next(int i, Unit& u) const { const int L = i * G + c; if (L < 1536) { const int q = L / 6; u.pm = q; u.pn = 2 + (L - 6 * q); return true; } if (L < 1536 + nctx) { u.pm = 256 + (L - 1536); u.pn = 5; return true; } return false; }
    DI void a_ready(const Unit&) const {}
    DI void done(const Unit&) const {}
    DI size_t offA(const Unit& u, size_t ts) const { return (size_t)u.pm * ts; }
    DI size_t offB(const Unit& u, size_t ts) const { return (size_t)u.pn * ts; }
    DI size_t halfB(size_t h) const { return h; }
};
struct CtxInOrder2 {
    int first, extra;
    DI bool next(int i, Unit& u) const { const int L = i == 0 ? first : extra; if (i >= 2 || L < 0) return false; const int q = L / 10; u.pm = 256 + q; u.pn = L - 10 * q; return true; }
    DI void a_ready(const Unit&) const {}
    DI void done(const Unit&) const {}
    DI size_t offA(const Unit& u, size_t ts) const { return (size_t)u.pm * ts; }
    DI size_t offB(const Unit& u, size_t ts) const { return (size_t)u.pn * ts; }
    DI size_t halfB(size_t h) const { return h; }
};
struct CtxZ1One {
    int pc;
    DI bool next(int i, Unit& u) const { if (i >= 1) return false; u.pm = 256 + pc; u.pn = 5; return true; }
    DI void a_ready(const Unit&) const {}
    DI void done(const Unit&) const {}
    DI size_t offA(const Unit& u, size_t ts) const { return (size_t)u.pm * ts; }
    DI size_t offB(const Unit& u, size_t ts) const { return (size_t)u.pn * ts; }
    DI size_t halfB(size_t h) const { return h; }
};
struct PanelOrder {
    int pm;
    DI bool next(int i, Unit& u) const { if (i >= 4) return false; u.pm = pm; u.pn = (i + pm) & 3; return true; }
    DI void a_ready(const Unit&) const {}
    DI void done(const Unit&) const {}
    DI size_t offA(const Unit& u, size_t ts) const { return (size_t)u.pm * ts; }
    DI size_t offB(const Unit& u, size_t ts) const { return (size_t)u.pn * ts; }
    DI size_t halfB(size_t h) const { return h; }
};
struct PanelOrder10 {
    int pm;
    DI bool next(int i, Unit& u) const { if (i >= 10) return false; u.pm = pm; u.pn = (i + pm) % 10; return true; }
    DI void a_ready(const Unit&) const {}
    DI void done(const Unit&) const {}
    DI size_t offA(const Unit& u, size_t ts) const { return (size_t)u.pm * ts; }
    DI size_t offB(const Unit& u, size_t ts) const { return (size_t)u.pn * ts; }
    DI size_t halfB(size_t h) const { return h; }
};
struct CtxInOrder {
    int G, c;
    DI bool next(int i, Unit& u) const { const int L = i * G + c; if (L >= 320) return false; const int q = L / 10; u.pm = 256 + q; u.pn = L - 10 * q; return true; }
    DI void a_ready(const Unit&) const {}
    DI void done(const Unit&) const {}
    DI size_t offA(const Unit& u, size_t ts) const { return (size_t)u.pm * ts; }
    DI size_t offB(const Unit& u, size_t ts) const { return (size_t)u.pn * ts; }
    DI size_t halfB(size_t h) const { return h; }
};
struct CtxOutOrder {
    int G, c;
    DI bool next(int i, Unit& u) const { const int L = i * G + c; if (L >= 128) return false; u.pm = 256 + (L >> 2); u.pn = L & 3; return true; }
    DI void a_ready(const Unit&) const {}
    DI void done(const Unit&) const {}
    DI size_t offA(const Unit& u, size_t ts) const { return (size_t)u.pm * ts; }
    DI size_t offB(const Unit& u, size_t ts) const { return (size_t)u.pn * ts; }
    DI size_t halfB(size_t h) const { return h; }
};
struct EpiZ1 {
    static constexpr bool PERM = true, AFTER_DRAIN = false;
    bf16_t* Z1; float* RQP; float* RKVP; bf16_t* KR; const float* ROPE;
    DI void operator()(const f32x4 (&acc)[2][2][4][2], const Unit& u, int wr, int wc, int fr, int fq) const {
        asm volatile("" : "+v"(fr), "+v"(fq));
        const int row0 = u.pm * BM + wr * 64 + fr, col0 = u.pn * BM + wc * 32 + 8 * fq;
        const bool odd = (fq & 1) != 0;
#pragma unroll
        for (int ai = 0; ai < 2; ++ai)
#pragma unroll
            for (int m = 0; m < 4; ++m) {
                const int row = row0 + ai * HALF + m * 16;
                bf16_t* orow = Z1 + (size_t)row * Z1LD + col0;
#pragma unroll
                for (int bj = 0; bj < 2; ++bj) { const f32x4 v0 = acc[ai][bj][m][0], v1 = acc[ai][bj][m][1];
                    u32x4 w; w.x = cvt_pk_bf16(v0[0], v0[1]); w.y = cvt_pk_bf16(v0[2], v0[3]); w.z = cvt_pk_bf16(v1[0], v1[1]); w.w = cvt_pk_bf16(v1[2], v1[3]);
                    *(u32x4*)(orow + bj * HALF) = w; }
                if (u.pn == 4 || u.pn == 5) {
                    float ss = 0.f;
#pragma unroll
                    for (int bj = 0; bj < 2; ++bj) if (u.pn == 4 || bj == 0) { const f32x4 v0 = acc[ai][bj][m][0], v1 = acc[ai][bj][m][1];
                        ss += (v0[0] * v0[0] + v0[1] * v0[1]) + (v0[2] * v0[2] + v0[3] * v0[3]) + (v1[0] * v1[0] + v1[1] * v1[1]) + (v1[2] * v1[2] + v1[3] * v1[3]); }
                    ss += __shfl_xor(ss, 16); ss += __shfl_xor(ss, 32);
                    if (fq == 0) { if (u.pn == 4) RQP[(size_t)row * 4 + wc] = ss; else RKVP[(size_t)row * 4 + wc] = ss; }
                    if (u.pn == 5 && wc == 0) {
                        f32x4 v[2] = {acc[ai][1][m][0], acc[ai][1][m][1]};
                        if (u.pm < 256) { const int t = row & 2047; const float pos = (float)(fq < 2 ? (t >> 6) : (t & 63));
#pragma unroll
                            for (int n = 0; n < 2; ++n) {
                                f32x4 cs, sn; rope_cs4(pos, n, cs, sn);
                                f32x4 oth;
#pragma unroll
                                for (int i = 0; i < 4; ++i) oth[i] = __shfl_xor(v[n][i], 16);
                                v[n] = odd ? (oth * sn + v[n] * cs) : (v[n] * cs - oth * sn); } }
                        u32x4 w; w.x = cvt_pk_bf16(v[0][0], v[0][1]); w.y = cvt_pk_bf16(v[0][2], v[0][3]); w.z = cvt_pk_bf16(v[1][0], v[1][1]); w.w = cvt_pk_bf16(v[1][2], v[1][3]);
                        *(u32x4*)(KR + (size_t)row * 32 + 8 * fq) = w; }
                }
                if (m & 1) asm volatile("" ::: "memory");
            }
    }
};
struct EpiOut1 {
    static constexpr bool PERM = true, AFTER_DRAIN = false;
    const float* MOD1; const h16_t* R0; h16_t* T; const float* ST1; const float* g;
    DI void operator()(const f32x4 (&acc)[2][2][4][2], const Unit& u, int wr, int wc, int fr, int fq) const {
        asm volatile("" : "+v"(fr), "+v"(fq));
        typedef _Float16 h16x8 __attribute__((ext_vector_type(8)));
        typedef float f32x2 __attribute__((ext_vector_type(2)));
        const int row0 = u.pm * BM + wr * 64 + fr, col0 = u.pn * BM + wc * 32 + 8 * fq;
        const float* gate = MOD1 + (u.pm >> 3) * 3072 + 2048 + col0;
        const h16_t* xb = R0 + (size_t)row0 * 2048 + col0; h16_t* ob = T + (size_t)row0 * DM + col0; const float* stp = ST1 + 2 * (size_t)row0;
        f32x4 gv[2][2], gA[2][2];
#pragma unroll
        for (int bj = 0; bj < 2; ++bj)
#pragma unroll
            for (int n = 0; n < 2; ++n) { gv[bj][n] = *(const f32x4*)(gate + bj * HALF + 4 * n); gA[bj][n] = *(const f32x4*)(g + col0 + bj * HALF + 4 * n) * ALPHA; }
        h16x8 xa[2][2], xc[2][2]; f32x2 sa[2], sc[2];
#define EO1_LOAD(X, S, bt) do { _Pragma("unroll") for (int mm = 0; mm < 2; ++mm) { const int r_ = ((bt) >> 1) * HALF + (((bt) & 1) * 2 + mm) * 16; S[mm] = *(const f32x2*)(stp + 2 * r_); \
            _Pragma("unroll") for (int bj = 0; bj < 2; ++bj) X[mm][bj] = *(const h16x8*)(xb + (size_t)r_ * 2048 + bj * HALF); } } while (0)
#define EO1_STORE(X, S, bt) do { _Pragma("unroll") for (int mm = 0; mm < 2; ++mm) { const int ai_ = (bt) >> 1, m_ = ((bt) & 1) * 2 + mm; const float mu_ = S[mm][0], rs_ = S[mm][1]; \
            _Pragma("unroll") for (int bj = 0; bj < 2; ++bj) { const h16x8 xv = X[mm][bj]; \
            const f32x4 x0 = {((float)xv[0] - mu_) * rs_, ((float)xv[1] - mu_) * rs_, ((float)xv[2] - mu_) * rs_, ((float)xv[3] - mu_) * rs_}, x1 = {((float)xv[4] - mu_) * rs_, ((float)xv[5] - mu_) * rs_, ((float)xv[6] - mu_) * rs_, ((float)xv[7] - mu_) * rs_}; \
            const f32x4 v0 = x0 * gA[bj][0] + gv[bj][0] * acc[ai_][bj][m_][0], v1 = x1 * gA[bj][1] + gv[bj][1] * acc[ai_][bj][m_][1]; \
            u32x4 w; w.x = pk_h2(v0[0], v0[1]); w.y = pk_h2(v0[2], v0[3]); w.z = pk_h2(v1[0], v1[1]); w.w = pk_h2(v1[2], v1[3]); \
            *(u32x4*)(ob + (size_t)(ai_ * HALF + m_ * 16) * DM + bj * HALF) = w; } } } while (0)
        EO1_LOAD(xa, sa, 0); EO1_LOAD(xc, sc, 1);
        EO1_STORE(xa, sa, 0); EO1_LOAD(xa, sa, 2);
        EO1_STORE(xc, sc, 1); EO1_LOAD(xc, sc, 3);
        EO1_STORE(xa, sa, 2); EO1_STORE(xc, sc, 3);
#undef EO1_LOAD
#undef EO1_STORE
    }
};
struct FoldOrder {
    int G, c;
    DI bool next(int i, Unit& u) const { const int L = i * G + c; if (L >= 512) return false; u.pm = L & 1; u.pn = L >> 1; return true; }
    DI void a_ready(const Unit&) const {}
    DI void done(const Unit&) const {}
    DI size_t offA(const Unit& u, size_t ts) const { return (size_t)u.pm * ts; }
    DI size_t offB(const Unit& u, size_t) const { return ((size_t)((u.pn >> 3) * 2048 + (u.pn & 7) * 128) * DM) * 2; }
    DI size_t halfB(size_t) const { return (size_t)1024 * DM * 2; }
};
struct EpiFold {
    static constexpr bool PERM = true, AFTER_DRAIN = false;
    bf16_t* GE; bf16_t* GO;
    DI void operator()(const f32x4 (&acc)[2][2][4][2], const Unit& u, int wr, int wc, int fr, int fq) const {
        asm volatile("" : "+v"(fr), "+v"(fq));
        const int ch0 = u.pm * BM + wr * 64 + fr; const size_t tok0 = (size_t)(u.pn >> 3) * 1024 + (u.pn & 7) * 128 + wc * 32 + 8 * fq;
#pragma unroll
        for (int ai = 0; ai < 2; ++ai)
#pragma unroll
            for (int m = 0; m < 4; ++m) {
                const size_t off = (size_t)(ch0 + ai * HALF + m * 16) * (NB * 1024) + tok0;
                const f32x4 e0 = acc[ai][0][m][0] + acc[ai][1][m][0], e1 = acc[ai][0][m][1] + acc[ai][1][m][1], o0 = acc[ai][0][m][0] - acc[ai][1][m][0], o1 = acc[ai][0][m][1] - acc[ai][1][m][1];
                u32x4 w; w.x = cvt_pk_bf16(e0[0], e0[1]); w.y = cvt_pk_bf16(e0[2], e0[3]); w.z = cvt_pk_bf16(e1[0], e1[1]); w.w = cvt_pk_bf16(e1[2], e1[3]);
                *(u32x4*)(GE + off) = w;
                w.x = cvt_pk_bf16(o0[0], o0[1]); w.y = cvt_pk_bf16(o0[2], o0[3]); w.z = cvt_pk_bf16(o1[0], o1[1]); w.w = cvt_pk_bf16(o1[2], o1[3]);
                *(u32x4*)(GO + off) = w;
            }
    }
};
struct EpiDft {
    static constexpr bool PERM = true, AFTER_DRAIN = false;
    bf16_t* SPEC;
    DI void operator()(const f32x4 (&acc)[2][2][4][2], const Unit& u, int wr, int wc, int fr, int fq) const {
        asm volatile("" : "+v"(fr), "+v"(fq));
        const int m0 = u.pm * BM + wr * 64 + fr, b = u.pn >> 1, part = u.pm >> 2, par = (u.pm >> 1) & 1, col0 = part * 512 + (u.pn & 1) * 256 + wc * 32 + 8 * fq;
        bf16_t* base = SPEC + (size_t)b * 2048 * DM + col0;
#pragma unroll
        for (int ai = 0; ai < 2; ++ai)
#pragma unroll
            for (int m = 0; m < 4; ++m) {
                const int k = 2 * ((m0 + ai * HALF + m * 16) & 511) + par;
#pragma unroll
                for (int bj = 0; bj < 2; ++bj) { const f32x4 v0 = acc[ai][bj][m][0], v1 = acc[ai][bj][m][1];
                    u32x4 w; w.x = cvt_pk_bf16(v0[0], v0[1]); w.y = cvt_pk_bf16(v0[2], v0[3]); w.z = cvt_pk_bf16(v1[0], v1[1]); w.w = cvt_pk_bf16(v1[2], v1[3]);
                    if (part == 0 || k) *(u32x4*)(base + (size_t)k * DM + bj * HALF) = w;
                    else {
                        *(u32x4*)(base - 512 + (size_t)1024 * DM + bj * HALF) = w;
                        const u32x4 z = {0u, 0u, 0u, 0u};
                        *(u32x4*)(base + bj * HALF) = z;
                    }
                }
            }
    }
};
struct DftOrder {
    int G, c;
    DI void init(int G_, int c_) { G = G_; c = c_; }
    DI bool next(int i, Unit& u) const { const int L = i * G + c; if (L >= 512) return false; u.pm = (L & 15) >> 1; u.pn = ((L >> 4) << 1) | (L & 1); return true; }
    DI void a_ready(const Unit&) const {}
    DI void done(const Unit&) const {}
    DI size_t offA(const Unit& u, size_t ts) const { return (size_t)u.pm * ts; }
    DI size_t offB(const Unit& u, size_t) const { return ((size_t)((u.pm >> 1) & 1) * 512 * (NB * 1024) + (size_t)(u.pn & 1) * 256 * (NB * 1024) + (size_t)(u.pn >> 1) * 1024) * 2; }
    DI size_t halfB(size_t h) const { return h; }
};
}

#define LAS __attribute__((address_space(3)))
#define GAS __attribute__((address_space(1)))
typedef unsigned v4u __attribute__((ext_vector_type(4)));
typedef float f32x4g __attribute__((ext_vector_type(4)));
DI unsigned pk2(float lo, float hi) { return (unsigned)f2bf(lo) | ((unsigned)f2bf(hi) << 16); }
#define LDS_WAIT() asm volatile("s_waitcnt lgkmcnt(0)" ::: "memory")

DI int win0_row(int n0) { return n0 < 1024 ? n0 : n0 < 1536 ? 1024 + 256 * ((n0 - 1024) >> 7) + ((n0 - 1024) & 127) : n0 < 2048 ? 2048 + (n0 - 1536) : 1024 + 256 * ((n0 - 2048) >> 7) + 128 + ((n0 - 2048) & 127); }
DI void transpose_item(const float* W, int K, int N, const float* kscale, bf16_t* WT, int ldwt, LAS float* scr, int item, int lane, bool remap0 = false) {
    const int nblk = N / 32, kb = item / nblk, nb = item % nblk, k0 = 64 * kb, n0 = 32 * nb; const int r0 = remap0 ? win0_row(n0) : n0;
    float tv[32];
#pragma unroll
    for (int i = 0; i < 32; ++i) tv[i] = W[(size_t)(k0 + 2 * i + (lane >> 5)) * N + n0 + (lane & 31)];
    if (kscale) {
#pragma unroll
        for (int i = 0; i < 32; ++i) tv[i] *= kscale[k0 + 2 * i + (lane >> 5)]; }
#pragma unroll
    for (int i = 0; i < 32; ++i) scr[(2 * i + (lane >> 5)) * 33 + (lane & 31)] = tv[i];
    LDS_WAIT(); asm volatile("" ::: "memory");
    const int c = lane & 7;
#pragma unroll
    for (int j = 0; j < 4; ++j) { const int n = (lane >> 3) + 8 * j; const LAS float* sp = scr + (8 * c) * 33 + n;
        v4u o; o.x = pk2(sp[0 * 33], sp[1 * 33]); o.y = pk2(sp[2 * 33], sp[3 * 33]); o.z = pk2(sp[4 * 33], sp[5 * 33]); o.w = pk2(sp[6 * 33], sp[7 * 33]);
        *(v4u*)(WT + (size_t)(r0 + n) * ldwt + k0 + 8 * c) = o; }
    LDS_WAIT(); asm volatile("" ::: "memory");
}

constexpr int NT = 512;

namespace att {
typedef short bf16x8 __attribute__((ext_vector_type(8)));
typedef short s16x4 __attribute__((ext_vector_type(4)));
typedef float f32x16 __attribute__((ext_vector_type(16)));
typedef __bf16 bf16x2_t __attribute__((ext_vector_type(2)));
typedef float f32x2_t __attribute__((ext_vector_type(2)));
constexpr int KSTR = 208, VSTR = 192, KBUF = 64 * KSTR, BUF = KBUF + 64 * VSTR;
constexpr int OFF_WS = 2 * BUF, OFF_OST = OFF_WS + 8 * 256, LDS_TOTAL = OFF_OST + 8 * 4096;
constexpr float THR = 8.f;
DI int crow(int r, int hi) { return (r & 3) + 8 * (r >> 2) + 4 * hi; }
DI unsigned cvtpk(float lo, float hi) { f32x2_t v = {lo, hi}; bf16x2_t b = __builtin_convertvector(v, bf16x2_t); return __builtin_bit_cast(unsigned, b); }
DI s16x4 vtr(const LAS unsigned char* p) { return __builtin_bit_cast(s16x4, __builtin_amdgcn_ds_read_tr16_b64_v4i16((LAS s16x4*)p)); }
DI float xhalf_max(float m) { auto rr = __builtin_amdgcn_permlane32_swap(__float_as_uint(m), __float_as_uint(m), false, false); return fmaxf(__uint_as_float(rr[0]), __uint_as_float(rr[1])); }
DI float xhalf_sum(float m) { auto rr = __builtin_amdgcn_permlane32_swap(__float_as_uint(m), __float_as_uint(m), false, false); return __uint_as_float(rr[0]) + __uint_as_float(rr[1]); }
DI size_t keyrow(int b, int t, int key) { return t < 4 ? (size_t)NLAT + b * 256 + t * 64 + key : (size_t)b * SEQ + (t - 4) * 64 + key; }

#define ATT_BAR_REAL() asm volatile("s_waitcnt lgkmcnt(0)\n\ts_barrier" ::: "memory")
#define ATT_BAR() do { if (MODE == 0) ATT_BAR_REAL(); } while (0)
template <int MODE> DI void attn_phase(unsigned char* lds_generic, const bf16_t* Q, const bf16_t* KV, const bf16_t* KR, const bf16_t* Z1, bf16_t* MIX1) {
    LAS unsigned char* L = (LAS unsigned char*)lds_generic;
    int tid_ = threadIdx.x; asm volatile("" : "+v"(tid_));
    const int tid = tid_, lane = tid & 63, r32 = lane & 31, hi = lane >> 5, wid = __builtin_amdgcn_readfirstlane(tid >> 6);
    const bool grpB = wid >= 4;
    const int G = gridDim.x, vcu = (G % 8 == 0) ? ((int)blockIdx.x % 8) * (G / 8) + (int)blockIdx.x / 8 : (int)blockIdx.x;
    LAS float* wsf = (LAS float*)(L + OFF_WS + wid * 256);
    LAS unsigned char* ost = L + OFF_OST + wid * 4096;
    const int skey = tid >> 3, sch = tid & 7, skey2 = (tid & 255) >> 2, sch2 = tid & 3;
    const int l16 = lane & 15, q4 = l16 >> 2, p4 = l16 & 3, cgrp = (lane >> 4) & 1;
    const int voff = (4 * hi + q4) * VSTR + (16 * cgrp + 4 * p4) * 2;
    const int koff = r32 * KSTR + hi * 16;
    for (int u = vcu; u < 2048; u += G) {
        const int qb = u & 7, h = (u >> 3) & 7, b = u >> 6;
        const int row0 = b * SEQ + qb * 256 + wid * 32;
        bf16x8 qr[6];
#pragma unroll
        for (int d0 = 0; d0 < 6; ++d0) qr[d0] = *(const bf16x8*)(Q + (size_t)(row0 + r32) * 768 + h * 96 + d0 * 16 + hi * 8);
        f32x16 o0, o1, negm, p0, p1;
#pragma unroll
        for (int r = 0; r < 16; ++r) { o0[r] = 0.f; o1[r] = 0.f; negm[r] = 0.f; p0[r] = 0.f; p1[r] = 0.f; }
        float m = 0.f, lsum = 0.f;
        v4u skn, sv, skr;
#define STAGE_LOAD(tt) do { const size_t kr0_ = keyrow(b, (tt), skey), kr2_ = keyrow(b, (tt), skey2); \
            skn = *(const v4u*)(KV + kr0_ * 1024 + h * 128 + sch * 8); sv = *(const v4u*)(KV + kr0_ * 1024 + h * 128 + 64 + sch * 8); \
            skr = *(const v4u*)(KR + kr2_ * 32 + sch2 * 8); } while (0)
#define STAGE_WRITE(bo) do { *(LAS v4u*)(L + (bo) + skey * KSTR + sch * 16) = skn; *(LAS v4u*)(L + (bo) + KBUF + skey * VSTR + sch * 16) = sv; \
            if (tid < 256) *(LAS v4u*)(L + (bo) + skey2 * KSTR + 128 + sch2 * 16) = skr; } while (0)
#define QK_STEP(bo, first) do { \
            const LAS unsigned char* kb_ = L + (bo) + koff; \
            bf16x8 kf_[12]; \
            _Pragma("unroll") for (int d0 = 0; d0 < 6; ++d0) { kf_[2 * d0] = *(const LAS bf16x8*)(kb_ + d0 * 32); kf_[2 * d0 + 1] = *(const LAS bf16x8*)(kb_ + 32 * KSTR + d0 * 32); } \
            p0 = __builtin_amdgcn_mfma_f32_32x32x16_bf16(kf_[0], qr[0], negm, 0, 0, 0); p1 = __builtin_amdgcn_mfma_f32_32x32x16_bf16(kf_[1], qr[0], negm, 0, 0, 0); \
            _Pragma("unroll") for (int d0 = 1; d0 < 6; ++d0) { \
                p0 = __builtin_amdgcn_mfma_f32_32x32x16_bf16(kf_[2 * d0], qr[d0], p0, 0, 0, 0); p1 = __builtin_amdgcn_mfma_f32_32x32x16_bf16(kf_[2 * d0 + 1], qr[d0], p1, 0, 0, 0); } \
            if (MODE == 2) break; \
            float ra_ = fmaxf(fmaxf(p0[0], p0[1]), p1[0]), rb_ = fmaxf(fmaxf(p0[2], p0[3]), p1[1]); ra_ = fmaxf(fmaxf(ra_, p1[2]), p1[3]); \
            _Pragma("unroll") for (int r = 4; r < 16; r += 4) { ra_ = fmaxf(fmaxf(ra_, p0[r]), p0[r + 1]); rb_ = fmaxf(fmaxf(rb_, p0[r + 2]), p0[r + 3]); ra_ = fmaxf(fmaxf(ra_, p1[r]), p1[r + 1]); rb_ = fmaxf(fmaxf(rb_, p1[r + 2]), p1[r + 3]); } \
            const float rel_ = xhalf_max(fmaxf(ra_, rb_)); \
            if (first) { m = rel_; \
                _Pragma("unroll") for (int r = 0; r < 16; ++r) { p0[r] -= rel_; p1[r] -= rel_; negm[r] = -m; } \
            } else if (__any(rel_ > THR)) { const float d_ = fmaxf(rel_, 0.f), al_ = __builtin_amdgcn_exp2f(-d_); \
                m += d_; lsum *= al_; \
                _Pragma("unroll") for (int r = 0; r < 16; ++r) { p0[r] -= d_; p1[r] -= d_; negm[r] = -m; } \
                if (hi == 0) wsf[r32] = al_; \
                _Pragma("unroll") for (int r = 0; r < 16; ++r) { const float f_ = wsf[crow(r, hi)]; o0[r] *= f_; o1[r] *= f_; } } \
        } while (0)
#define SMPV_STEP(bo) do { \
            const LAS unsigned char* vb_ = L + (bo) + KBUF + voff; \
            s16x4 vl_[8], vh_[8]; \
            _Pragma("unroll") for (int ks = 0; ks < 4; ++ks) { const LAS unsigned char* vk_ = vb_ + ks * 16 * VSTR; \
                vl_[2 * ks] = vtr(vk_); vh_[2 * ks] = vtr(vk_ + 8 * VSTR); vl_[2 * ks + 1] = vtr(vk_ + 64); vh_[2 * ks + 1] = vtr(vk_ + 8 * VSTR + 64); } \
            float ps_ = 0.f; \
            if (MODE != 2) { _Pragma("unroll") for (int r = 0; r < 16; ++r) { p0[r] = __builtin_amdgcn_exp2f(p0[r]); p1[r] = __builtin_amdgcn_exp2f(p1[r]); ps_ += p0[r] + p1[r]; } } else ps_ = p0[0]; \
            lsum += ps_; \
            _Pragma("unroll") for (int ks = 0; ks < 4; ++ks) { \
                v4u pw_; \
                if (ks < 2) { pw_.x = cvtpk(p0[8 * ks + 0], p0[8 * ks + 1]); pw_.y = cvtpk(p0[8 * ks + 2], p0[8 * ks + 3]); pw_.z = cvtpk(p0[8 * ks + 4], p0[8 * ks + 5]); pw_.w = cvtpk(p0[8 * ks + 6], p0[8 * ks + 7]); } \
                else { pw_.x = cvtpk(p1[8 * ks - 16], p1[8 * ks - 15]); pw_.y = cvtpk(p1[8 * ks - 14], p1[8 * ks - 13]); pw_.z = cvtpk(p1[8 * ks - 12], p1[8 * ks - 11]); pw_.w = cvtpk(p1[8 * ks - 10], p1[8 * ks - 9]); } \
                const bf16x8 pa_ = __builtin_bit_cast(bf16x8, pw_); \
                const bf16x8 v0_ = {vl_[2 * ks][0], vl_[2 * ks][1], vl_[2 * ks][2], vl_[2 * ks][3], vh_[2 * ks][0], vh_[2 * ks][1], vh_[2 * ks][2], vh_[2 * ks][3]}; \
                const bf16x8 v1_ = {vl_[2 * ks + 1][0], vl_[2 * ks + 1][1], vl_[2 * ks + 1][2], vl_[2 * ks + 1][3], vh_[2 * ks + 1][0], vh_[2 * ks + 1][1], vh_[2 * ks + 1][2], vh_[2 * ks + 1][3]}; \
                o0 = __builtin_amdgcn_mfma_f32_32x32x16_bf16(pa_, v0_, o0, 0, 0, 0); \
                o1 = __builtin_amdgcn_mfma_f32_32x32x16_bf16(pa_, v1_, o1, 0, 0, 0); } \
        } while (0)
        STAGE_LOAD(0); STAGE_WRITE(0); STAGE_WRITE(BUF);
        ATT_BAR_REAL();
        if (!grpB) {
            for (int t = 0; t < 36; ++t) {
                const int cur = (t & 1) * BUF, nxt = BUF - cur;
                if (MODE == 0 && t + 1 < 36) STAGE_LOAD(t + 1);
                QK_STEP(cur, t == 0);
                ATT_BAR();
                SMPV_STEP(cur);
                if (MODE == 0 && t + 1 < 36) STAGE_WRITE(nxt);
                ATT_BAR();
            }
        } else {
            for (int t = 0; t < 36; ++t) {
                const int cur = (t & 1) * BUF, nxt = BUF - cur;
                if (MODE == 0 && t + 1 < 36) STAGE_LOAD(t + 1);
                if (t > 0) SMPV_STEP(nxt);
                ATT_BAR();
                QK_STEP(cur, t == 0);
                if (MODE == 0 && t + 1 < 36) STAGE_WRITE(nxt);
                ATT_BAR();
            }
            SMPV_STEP(BUF);
        }
#undef STAGE_LOAD
#undef STAGE_WRITE
#undef QK_STEP
#undef SMPV_STEP
        lsum = xhalf_sum(lsum);
        if (hi == 0) wsf[32 + r32] = lsum;
#pragma unroll
        for (int r = 0; r < 16; ++r) { const float il = __builtin_amdgcn_rcpf(wsf[32 + crow(r, hi)]); const int q = crow(r, hi);
            *(LAS bf16_t*)(ost + q * 128 + r32 * 2) = f2bf(o0[r] * il); *(LAS bf16_t*)(ost + q * 128 + 64 + r32 * 2) = f2bf(o1[r] * il); }
        v4u gvv[4];
#pragma unroll
        for (int i = 0; i < 4; ++i) gvv[i] = *(const v4u*)(Z1 + (size_t)(row0 + i * 8 + (lane >> 3)) * Z1LD + 1440 + h * 64 + (lane & 7) * 8);
#pragma unroll
        for (int i = 0; i < 4; ++i) {
            const int row = i * 8 + (lane >> 3), ch = lane & 7;
            const v4u ov = *(const LAS v4u*)(ost + row * 128 + ch * 16);
            const v4u gv = gvv[i];
            v4u w;
#pragma unroll
            for (int j = 0; j < 4; ++j) { const float a0 = __uint_as_float(ov[j] << 16), a1 = __uint_as_float(ov[j] & 0xffff0000u), g0 = __uint_as_float(gv[j] << 16), g1 = __uint_as_float(gv[j] & 0xffff0000u);
                w[j] = cvtpk(a0 * pg8::silu_fast(g0), a1 * pg8::silu_fast(g1)); }
            *(v4u*)(MIX1 + (size_t)(row0 + row) * DM + 512 + h * 64 + ch * 8) = w;
        }
        if (MODE != 0) ATT_BAR_REAL();
    }
}
}

#define XB_TMO      128
#define XB_XCNT(j)  (256  + 64 * (j))
#define XB_XSUB(j)  (1280 + 64 * (j))
#define XB_XGEN(j)  (2304 + 64 * (j))
#define XB_TOP      3328
#define XB_TOPGEN   3392
#define XCD_BAR_WORDS 3456
#define XB_SPIN_CAP (1u << 18)

__device__ __forceinline__ unsigned xb_ld(unsigned* p)              { return __hip_atomic_load(p, __ATOMIC_RELAXED, __HIP_MEMORY_SCOPE_AGENT); }
__device__ __forceinline__ unsigned xb_add(unsigned* p, unsigned v) { return __hip_atomic_fetch_add(p, v, __ATOMIC_RELAXED, __HIP_MEMORY_SCOPE_AGENT); }
__device__ __forceinline__ unsigned xb_xcc_id() { return (unsigned)__builtin_amdgcn_s_getreg((3 << 11) | 20) & 0xFu; }
#define XB_SPIN(cond, bar) do { unsigned _sp = 0; while (cond) { __builtin_amdgcn_s_sleep(1); \
    if ((++_sp & 255u) == 0u) { if (xb_ld(&(bar)[XB_TMO])) break; if (_sp > XB_SPIN_CAP) { atomicAdd(&(bar)[XB_TMO], 1u); break; } } } } while (0)

namespace mixp {
typedef short bf16x8 __attribute__((ext_vector_type(8)));
typedef short s16x4 __attribute__((ext_vector_type(4)));
typedef float f32x16 __attribute__((ext_vector_type(16)));
constexpr int WSTR = 272, XSTR = 320, ASTR = 272;
constexpr int OFF_WT = 0, OFF_X = 128 * WSTR, OFF_AH = OFF_X + 128 * XSTR, LDS_TOTAL = OFF_AH + 144 * ASTR;
DI void unpack8(const v4u& v, float (&f)[8]) {
#pragma unroll
    for (int i = 0; i < 4; ++i) { f[2 * i] = __uint_as_float(v[i] << 16); f[2 * i + 1] = __uint_as_float(v[i] & 0xffff0000u); } }
DI v4u pack8(const float (&f)[8]) { return (v4u){att::cvtpk(f[0], f[1]), att::cvtpk(f[2], f[3]), att::cvtpk(f[4], f[5]), att::cvtpk(f[6], f[7])}; }

template <bool POOL>
DI void mixer_items(LAS unsigned char* L, const int gh, const bf16_t* Z0, const float* pscale, const float* sgu_b, bf16_t* MIX0, unsigned* flag, const unsigned need, unsigned* bar) {
    int tid_ = threadIdx.x; asm volatile("" : "+v"(tid_));
    const int tid = tid_, lane = tid & 63, r32 = lane & 31, hi = lane >> 5, wid = __builtin_amdgcn_readfirstlane(tid >> 6), wr = wid >> 1, wc = wid & 1;
    const int G = gridDim.x, c = blockIdx.x;
    const int l16 = lane & 15, q4 = l16 >> 2, p4 = l16 & 3, cgrp = (lane >> 4) & 1;
    constexpr int NPRE = POOL ? 5 : 4;
    v4u pre[NPRE], gA[4];
    const int cstep = G >> 3, nchunk = NROW / 128;
#define MIX_PREFETCH(chunk_) do { const int rb_ = (chunk_) * 128; \
        if (POOL) { const RowInfo ri_ = rowinfo(rb_); \
            _Pragma("unroll") for (int i = 0; i < 5; ++i) { const int e = tid + NT * i, rr = e >> 4, ch = e & 15, t = ri_.t - 8 + rr; \
                if (e < 144 * 16 && t >= 0 && t < ri_.L) pre[i] = *(const v4u*)(Z0 + Z0OFF(gh, ri_.base + t) + ch * 8); } \
        } else { const bf16_t* vp_ = Z0 + Z0OFF(12 + gh, rb_ + (tid >> 2)) + (tid & 3) * 32; \
            _Pragma("unroll") for (int k = 0; k < 4; ++k) pre[k] = *(const v4u*)(vp_ + k * 8); } } while (0)
    int chunk = c >> 3; bool waited = false;
    if (chunk < nchunk) MIX_PREFETCH(chunk);
    for (; chunk < nchunk; chunk += cstep) {
        const int row_base = chunk * 128;
        const RowInfo ri = rowinfo(row_base);
        __syncthreads();
        if (POOL) {
#pragma unroll
            for (int i = 0; i < 5; ++i) { const int e = tid + NT * i, rr = e >> 4, ch = e & 15, t = ri.t - 8 + rr;
                if (e < 144 * 16 && t >= 0 && t < ri.L) *(LAS v4u*)(L + OFF_AH + rr * ASTR + ch * 16) = pre[i]; }
        } else {
            const int tl = tid >> 2, cq = tid & 3;
            float f[4][8]; float sm = 0.f;
#pragma unroll
            for (int k = 0; k < 4; ++k) { unpack8(pre[k], f[k]);
#pragma unroll
                for (int i = 0; i < 8; ++i) sm += f[k][i]; }
            sm += __shfl_xor(sm, 1); sm += __shfl_xor(sm, 2);
            const float mu = sm * (1.f / 128.f); float qs = 0.f;
#pragma unroll
            for (int k = 0; k < 4; ++k)
#pragma unroll
                for (int i = 0; i < 8; ++i) { f[k][i] -= mu; qs += f[k][i] * f[k][i]; }
            qs += __shfl_xor(qs, 1); qs += __shfl_xor(qs, 2);
            const float rs = rsqrtf(qs * (1.f / 128.f) + EPS);
#pragma unroll
            for (int k = 0; k < 4; ++k) {
#pragma unroll
                for (int i = 0; i < 8; ++i) f[k][i] *= rs;
                *(LAS v4u*)(L + OFF_X + tl * XSTR + (cq * 4 + k) * 16) = pack8(f[k]); }
        }
#pragma unroll
        for (int it = 0; it < 4; ++it) { const size_t grow = (size_t)row_base + 32 * wr + it * 8 + (lane >> 3); const int col = 64 * wc + (lane & 7) * 8;
            gA[it] = *(const v4u*)(Z0 + Z0OFF((POOL ? 4 : 8) + gh, grow) + col); }
        if (flag && !waited && chunk + cstep >= NLAT / 128) {
            if (threadIdx.x == 0) { XB_SPIN(xb_ld(flag) < need, bar); __builtin_amdgcn_fence(__ATOMIC_ACQUIRE, "agent"); asm volatile("s_waitcnt vmcnt(0)" ::: "memory"); }
            __syncthreads(); waited = true; }
        if (chunk + cstep < nchunk) MIX_PREFETCH(chunk + cstep);
        __syncthreads();
        if (POOL) {
            const int w = 2 << gh, ch = tid & 15, ts = (tid >> 4) * 4, t0 = ri.t;
            float acc[8];
#pragma unroll
            for (int i = 0; i < 8; ++i) acc[i] = 0.f;
            int lo = t0 + ts - (w >> 1); if (lo < 0) lo = 0; int hh = t0 + ts + (w >> 1); if (hh > ri.L) hh = ri.L;
            for (int tt = lo; tt < hh; ++tt) { float f[8]; { const v4u tv = *(const LAS v4u*)(L + OFF_AH + (tt - t0 + 8) * ASTR + ch * 16); unpack8(tv, f); }
#pragma unroll
                for (int i = 0; i < 8; ++i) acc[i] += f[i]; }
#pragma unroll
            for (int k = 0; k < 4; ++k) {
                const int t = t0 + ts + k;
                if (k) { int nlo = t - (w >> 1); if (nlo < 0) nlo = 0; int nhh = t + (w >> 1); if (nhh > ri.L) nhh = ri.L;
                    if (nhh > hh) { float f[8]; { const v4u tv = *(const LAS v4u*)(L + OFF_AH + (hh - t0 + 8) * ASTR + ch * 16); unpack8(tv, f); }
#pragma unroll
                        for (int i = 0; i < 8; ++i) acc[i] += f[i]; }
                    if (nlo > lo) { float f[8]; { const v4u tv = *(const LAS v4u*)(L + OFF_AH + (lo - t0 + 8) * ASTR + ch * 16); unpack8(tv, f); }
#pragma unroll
                        for (int i = 0; i < 8; ++i) acc[i] -= f[i]; }
                    lo = nlo; hh = nhh; }
                const float inv = 1.f / (float)(hh - lo);
                float a[8], d[8]; { const v4u tv = *(const LAS v4u*)(L + OFF_AH + (ts + k + 8) * ASTR + ch * 16); unpack8(tv, a); }
#pragma unroll
                for (int i = 0; i < 8; ++i) d[i] = acc[i] * inv - a[i];
                *(LAS v4u*)(L + OFF_X + (ts + k) * WSTR + ch * 16) = pack8(d);
            }
            __syncthreads();
        }
        f32x16 acc0, acc1;
#pragma unroll
        for (int r = 0; r < 16; ++r) { acc0[r] = 0.f; acc1[r] = 0.f; }
        if (POOL) {
            const LAS unsigned char* ap = L + OFF_X + (32 * wr + r32) * WSTR + hi * 16;
            const LAS unsigned char* bp = L + OFF_WT + (64 * wc + r32) * WSTR + hi * 16;
#pragma unroll
            for (int ks = 0; ks < 8; ++ks) {
                const bf16x8 a = *(const LAS bf16x8*)(ap + ks * 32), b0 = *(const LAS bf16x8*)(bp + ks * 32), b1 = *(const LAS bf16x8*)(bp + 32 * WSTR + ks * 32);
                acc0 = __builtin_amdgcn_mfma_f32_32x32x16_bf16(a, b0, acc0, 0, 0, 0); acc1 = __builtin_amdgcn_mfma_f32_32x32x16_bf16(a, b1, acc1, 0, 0, 0); }
        } else {
            const LAS unsigned char* ap = L + OFF_WT + (32 * wr + r32) * WSTR + hi * 16;
            const LAS unsigned char* vb = L + OFF_X + (8 * hi + q4) * XSTR + (64 * wc + 16 * cgrp + 4 * p4) * 2;
#pragma unroll
            for (int ks = 0; ks < 8; ++ks) {
                const bf16x8 a = *(const LAS bf16x8*)(ap + ks * 32);
                const LAS unsigned char* vk = vb + ks * 16 * XSTR;
                const s16x4 l0 = att::vtr(vk), h0 = att::vtr(vk + 4 * XSTR), l1 = att::vtr(vk + 64), h1 = att::vtr(vk + 4 * XSTR + 64);
                const bf16x8 b0 = {l0[0], l0[1], l0[2], l0[3], h0[0], h0[1], h0[2], h0[3]}, b1 = {l1[0], l1[1], l1[2], l1[3], h1[0], h1[1], h1[2], h1[3]};
                acc0 = __builtin_amdgcn_mfma_f32_32x32x16_bf16(a, b0, acc0, 0, 0, 0); acc1 = __builtin_amdgcn_mfma_f32_32x32x16_bf16(a, b1, acc1, 0, 0, 0); }
        }
        __syncthreads();
        LAS unsigned char* ost = L + OFF_X + wid * 4096;
#pragma unroll
        for (int r = 0; r < 16; ++r) { const int q = att::crow(r, hi);
            *(LAS bf16_t*)(ost + q * 128 + r32 * 2) = f2bf(acc0[r]); *(LAS bf16_t*)(ost + q * 128 + 64 + r32 * 2) = f2bf(acc1[r]); }
        f32x4g ps0 = {0.f, 0.f, 0.f, 0.f}, ps1 = ps0; float biasv[4] = {0.f, 0.f, 0.f, 0.f};
        if (POOL) { ps0 = *(const f32x4g*)(pscale + gh * 128 + 64 * wc + (lane & 7) * 8); ps1 = *(const f32x4g*)(pscale + gh * 128 + 64 * wc + (lane & 7) * 8 + 4); }
        else {
#pragma unroll
            for (int it = 0; it < 4; ++it) biasv[it] = sgu_b[gh * 128 + 32 * wr + it * 8 + (lane >> 3)]; }
#pragma unroll
        for (int it = 0; it < 4; ++it) {
            const int row = it * 8 + (lane >> 3), ch = lane & 7, col = 64 * wc + ch * 8;
            const size_t grow = (size_t)row_base + 32 * wr + row;
            float y[8]; { const v4u tv = *(const LAS v4u*)(ost + row * 128 + ch * 16); unpack8(tv, y); }
            float o[8];
            if (POOL) {
                float ga[8]; unpack8(gA[it], ga);
#pragma unroll
                for (int i = 0; i < 8; ++i) o[i] = y[i] * (i < 4 ? ps0[i & 3] : ps1[i & 3]) * ga[i];
                *(v4u*)(MIX0 + grow * DM + gh * 128 + col) = pack8(o);
            } else {
                float ug[8]; unpack8(gA[it], ug);
                const float bias = biasv[it];
#pragma unroll
                for (int i = 0; i < 8; ++i) o[i] = (y[i] + bias) * ug[i];
                *(v4u*)(MIX0 + grow * DM + 512 + gh * 128 + col) = pack8(o);
            }
        }
    }
#undef MIX_PREFETCH
}
DI void mixer_phase(unsigned char* lds_generic, const bf16_t* Z0, const bf16_t* WPOOL, const bf16_t* WSGU, const float* pscale, const float* sgu_b, bf16_t* MIX0, unsigned* flag, const unsigned need, unsigned* bar) {
    LAS unsigned char* L = (LAS unsigned char*)lds_generic;
    const int tid = threadIdx.x, j = blockIdx.x & 7, gh = j & 3;
    {   const bf16_t* W = (j < 4 ? WPOOL : WSGU) + gh * 16384;
        __syncthreads();
#pragma unroll
        for (int i = 0; i < 4; ++i) { const int e = tid + NT * i, row = e >> 4, ch = e & 15; *(LAS v4u*)(L + OFF_WT + row * WSTR + ch * 16) = *(const v4u*)(W + row * 128 + ch * 8); }
    }
    if (j < 4) mixer_items<true>(L, gh, Z0, pscale, sgu_b, MIX0, flag, need, bar); else mixer_items<false>(L, gh, Z0, pscale, sgu_b, MIX0, flag, need, bar);
}
}
struct XcdBarrier {
    unsigned* bar; unsigned x;
    volatile LAS unsigned* st;
};

__device__ __forceinline__ XcdBarrier xcd_barrier_post(unsigned* bar, volatile LAS unsigned* st) {
    XcdBarrier b; b.bar = bar; b.x = xb_xcc_id(); b.st = st;
    if (threadIdx.x == 0) (void)xb_add(&bar[XB_XCNT(b.x)], 1u);
    return b;
}
__device__ __forceinline__ void xcd_barrier_complete(unsigned* bar, unsigned x, unsigned& nloc, unsigned& nx) {
    const unsigned G = gridDim.x * gridDim.y * gridDim.z;
    unsigned sum, cnt, mine, sp = 0u;
    for (;;) {
        sum = 0u; cnt = 0u; mine = 0u;
#pragma unroll
        for (unsigned j = 0; j < 16; ++j) { const unsigned c = xb_ld(&bar[XB_XCNT(j)]); sum += c; cnt += (c > 0u) ? 1u : 0u; mine = (j == x) ? c : mine; }
        if (sum == G) break;
        __builtin_amdgcn_s_sleep(1);
        if ((++sp & 255u) == 0u) { if (xb_ld(&bar[XB_TMO])) break; if (sp > XB_SPIN_CAP) { atomicAdd(&bar[XB_TMO], 1u); break; } }
    }
    nloc = mine > 0u ? mine : 1u; nx = cnt > 0u ? cnt : 1u;
}

__device__ __forceinline__ void xcd_barrier(const XcdBarrier& b) {
    asm volatile("s_waitcnt vmcnt(0)" ::: "memory");
    __syncthreads();
    if (threadIdx.x == 0) {
        unsigned* bar = b.bar;
        __builtin_amdgcn_s_waitcnt(0);
        unsigned nloc = b.st[0], nx = b.st[1];
        if (nloc == 0u) { xcd_barrier_complete(bar, b.x, nloc, nx); b.st[0] = nloc; b.st[1] = nx; }
        const unsigned old = xb_add(&bar[XB_XSUB(b.x)], 1u);
        const unsigned gen = old / nloc;
        if (old + 1u == (gen + 1u) * nloc) {
            __builtin_amdgcn_fence(__ATOMIC_RELEASE, "agent");
            asm volatile("s_waitcnt vmcnt(0)" ::: "memory");
            const unsigned og = xb_add(&bar[XB_TOP], 1u);
            const unsigned tg = og / nx;
            if (og + 1u == (tg + 1u) * nx) xb_add(&bar[XB_TOPGEN], 1u);
            else XB_SPIN(xb_ld(&bar[XB_TOPGEN]) == tg, bar);
            __builtin_amdgcn_fence(__ATOMIC_ACQUIRE, "agent");
            xb_add(&bar[XB_XGEN(b.x)], 1u);
            asm volatile("s_waitcnt vmcnt(0)" ::: "memory");
        } else {
            XB_SPIN(xb_ld(&bar[XB_XGEN(b.x)]) == gen, bar);
            __builtin_amdgcn_fence(__ATOMIC_ACQUIRE, "agent");
            asm volatile("s_waitcnt vmcnt(0)" ::: "memory");
        }
    }
    __syncthreads();
}


typedef unsigned u32x2g __attribute__((ext_vector_type(2)));
DI void h0_rows(int r0, int n, int w0, int nw, const float* x, const float* ctx, const float* MOD0, bf16_t* H0) {
    int lane = threadIdx.x & 63; asm volatile("" : "+v"(lane), "+v"(w0));
    const float* mod = MOD0 + (r0 < NLAT ? (r0 >> 11) : 32) * 3072;
    f32x4g sc[4], sh[4];
#pragma unroll
    for (int j = 0; j < 4; ++j) { sc[j] = *(const f32x4g*)(mod + 1024 + 4 * lane + 256 * j) + 1.f; sh[j] = *(const f32x4g*)(mod + 4 * lane + 256 * j); }
    for (int rb = r0 + w0; rb < r0 + n; rb += 4 * nw) {
        f32x4g xv[4][4];
#pragma unroll
        for (int q = 0; q < 4; ++q) { int row = rb + q * nw; if (row >= r0 + n) row = rb;
            const float* src = row < NLAT ? x + (size_t)row * DM : ctx + (size_t)(row - NLAT) * DM;
#pragma unroll
            for (int j = 0; j < 4; ++j) xv[q][j] = *(const f32x4g*)(src + 4 * lane + 256 * j); }
#pragma unroll
        for (int q = 0; q < 4; ++q) { const int row = rb + q * nw; if (row >= r0 + n) break;
#pragma unroll
            for (int j = 0; j < 4; ++j) { const int col = 4 * lane + 256 * j;
                const f32x4g h = xv[q][j] * sc[j] + sh[j];
                *(u32x2g*)(H0 + (size_t)row * DM + col) = (u32x2g){att::cvtpk(h[0], h[1]), att::cvtpk(h[2], h[3])}; } }
    }
}
typedef _Float16 h16x8g __attribute__((ext_vector_type(8)));
template <bool ADD>
DI void ln_load_stats4(const h16_t* src, size_t ld, int row0, int rstep, int rend, float (&v)[4][16], float (&mu)[4], float (&rs)[4], int lane, const f32x4g (&ad)[4]) {
    h16x8g hv[4][2];
#pragma unroll
    for (int q = 0; q < 4; ++q) { int row = row0 + q * rstep; if (row >= rend) row = row0;
#pragma unroll
        for (int j = 0; j < 2; ++j) hv[q][j] = *(const h16x8g*)(src + (size_t)row * ld + 8 * lane + 512 * j); }
    float s[4], ss[4];
#pragma unroll
    for (int q = 0; q < 4; ++q) { s[q] = 0.f; ss[q] = 0.f;
#pragma unroll
        for (int j = 0; j < 2; ++j)
#pragma unroll
            for (int i = 0; i < 8; ++i) { const float f = (float)hv[q][j][i] + (ADD ? ad[2 * j + (i >> 2)][i & 3] : 0.f); v[q][8 * j + i] = f; s[q] += f; ss[q] += f * f; } }
#pragma unroll
    for (int o = 1; o < 64; o <<= 1)
#pragma unroll
        for (int q = 0; q < 4; ++q) { s[q] += __shfl_xor(s[q], o); ss[q] += __shfl_xor(ss[q], o); }
#pragma unroll
    for (int q = 0; q < 4; ++q) { mu[q] = s[q] * (1.f / DM); const float var = fmaxf(ss[q] * (1.f / DM) - mu[q] * mu[q], 0.f); rs[q] = rsqrtf(var + EPS); }
}
DI void ln0_rows(int r0, int n, const h16_t* R0, size_t ld, const float* g, const float* bta, const float* MOD1, float* ST1, bf16_t* H1) {
    int wv = threadIdx.x >> 6, lane = threadIdx.x & 63; asm volatile("" : "+v"(wv), "+v"(lane));
    const float* mod = MOD1 + (r0 < NLAT ? (r0 >> 11) : 32) * 3072;
    f32x4g gg[4], bb[4], sc[4], sh[4];
#pragma unroll
    for (int j = 0; j < 2; ++j)
#pragma unroll
        for (int i4 = 0; i4 < 2; ++i4) { const int col = 8 * lane + 512 * j + 4 * i4;
            gg[2 * j + i4] = *(const f32x4g*)(g + col); bb[2 * j + i4] = *(const f32x4g*)(bta + col); sc[2 * j + i4] = *(const f32x4g*)(mod + 1024 + col) + 1.f; sh[2 * j + i4] = *(const f32x4g*)(mod + col); }
    for (int rb = r0 + wv; rb < r0 + n; rb += 32) {
        float v[4][16], mu[4], rs[4];
        ln_load_stats4<false>(R0, ld, rb, 8, r0 + n, v, mu, rs, lane, gg);
#pragma unroll
        for (int q = 0; q < 4; ++q) { const int row = rb + 8 * q; if (row >= r0 + n) break;
            if (lane == 0 && row < NLAT) { ST1[2 * (size_t)row] = mu[q]; ST1[2 * (size_t)row + 1] = rs[q]; }
#pragma unroll
            for (int j = 0; j < 2; ++j) { const int col = 8 * lane + 512 * j; float x1[8], hh[8];
#pragma unroll
                for (int i4 = 0; i4 < 2; ++i4)
#pragma unroll
                    for (int i = 0; i < 4; ++i) { x1[4 * i4 + i] = (v[q][8 * j + 4 * i4 + i] - mu[q]) * rs[q] * gg[2 * j + i4][i] + bb[2 * j + i4][i]; hh[4 * i4 + i] = x1[4 * i4 + i] * sc[2 * j + i4][i] + sh[2 * j + i4][i]; }
                *(v4u*)(H1 + (size_t)row * DM + col) = (v4u){att::cvtpk(hh[0], hh[1]), att::cvtpk(hh[2], hh[3]), att::cvtpk(hh[4], hh[5]), att::cvtpk(hh[6], hh[7])}; } }
    }
}
DI void ln1_rows(int r0, int n, const h16_t* T, const float* b0, const float* g, const float* bta, float* out) {
    int wv = threadIdx.x >> 6, lane = threadIdx.x & 63; asm volatile("" : "+v"(wv), "+v"(lane));
    f32x4g gg[4], bb[4], ba[4];
#pragma unroll
    for (int j = 0; j < 2; ++j)
#pragma unroll
        for (int i4 = 0; i4 < 2; ++i4) { const int col = 8 * lane + 512 * j + 4 * i4; gg[2 * j + i4] = *(const f32x4g*)(g + col); bb[2 * j + i4] = *(const f32x4g*)(bta + col); ba[2 * j + i4] = *(const f32x4g*)(b0 + col) * ALPHA; }
    for (int rb = r0 + wv; rb < r0 + n; rb += 32) {
        float v[4][16], mu[4], rs[4];
        ln_load_stats4<true>(T, DM, rb, 8, r0 + n, v, mu, rs, lane, ba);
#pragma unroll
        for (int q = 0; q < 4; ++q) { const int row = rb + 8 * q; if (row >= r0 + n) break;
#pragma unroll
            for (int j = 0; j < 2; ++j) { const int col = 8 * lane + 512 * j;
#pragma unroll
                for (int i4 = 0; i4 < 2; ++i4) { f32x4g o;
#pragma unroll
                    for (int i = 0; i < 4; ++i) o[i] = (v[q][8 * j + 4 * i4 + i] - mu[q]) * rs[q] * gg[2 * j + i4][i] + bb[2 * j + i4][i];
                    *(f32x4g*)(out + (size_t)row * DM + col + 4 * i4) = o; } } }
    }
}
DI void split_bf16x8(const float (&v)[8], pg8::bf16x8& hi, pg8::bf16x8& lo) {
    pg8::u32x4 h, l;
#pragma unroll
    for (int i = 0; i < 4; ++i) { h[i] = pg8::cvt_pk_bf16(v[2 * i], v[2 * i + 1]);
        l[i] = pg8::cvt_pk_bf16(v[2 * i] - __uint_as_float(h[i] << 16), v[2 * i + 1] - __uint_as_float(h[i] & 0xffff0000u)); }
    hi = __builtin_bit_cast(pg8::bf16x8, h); lo = __builtin_bit_cast(pg8::bf16x8, l);
}
DI void ph_mod(unsigned char* lds_generic, const float* c, const float* c_ctx, const float* w0, const float* b0, const float* w1, const float* b1, float* MOD0, float* MOD1) {
    LAS float* red = (LAS float*)lds_generic;
    int tid_ = threadIdx.x; asm volatile("" : "+v"(tid_));
    const int tid = tid_, wv = tid >> 6, l = tid & 63, l15 = l & 15, lq = l >> 4;
    for (int item = blockIdx.x; item < 192; item += gridDim.x) {
        const int layer = item / 96, n0 = (item % 96) * 32;
        const float* w = layer ? w1 : w0; const float* bb = layer ? b1 : b0; float* outp = layer ? MOD1 : MOD0;
        pg8::f32x4 acc[2][3];
#pragma unroll
        for (int a = 0; a < 2; ++a)
#pragma unroll
            for (int b = 0; b < 3; ++b) acc[a][b] = (pg8::f32x4){0.f, 0.f, 0.f, 0.f};
        for (int s4 = 0; s4 < 4; ++s4) {
            const int kb = 128 * wv + 32 * s4 + 8 * lq;
            float wf[2][8];
#pragma unroll
            for (int nt = 0; nt < 2; ++nt)
#pragma unroll
                for (int j = 0; j < 8; ++j) wf[nt][j] = w[(size_t)(kb + j) * 3072 + n0 + 16 * nt + l15];
            pg8::bf16x8 chi[3], clo[3];
#pragma unroll
            for (int rt = 0; rt < 3; ++rt) {
                const int r = 16 * rt + l15; float cv[8];
                if (r <= 32) { const float* cp = (r < 32 ? c + (size_t)r * DM : c_ctx) + kb; const f32x4g c0 = *(const f32x4g*)cp, c1 = *(const f32x4g*)(cp + 4);
#pragma unroll
                    for (int j = 0; j < 4; ++j) { cv[j] = silu(c0[j]); cv[4 + j] = silu(c1[j]); } }
                else {
#pragma unroll
                    for (int j = 0; j < 8; ++j) cv[j] = 0.f; }
                split_bf16x8(cv, chi[rt], clo[rt]);
            }
#pragma unroll
            for (int nt = 0; nt < 2; ++nt) { pg8::bf16x8 whi, wlo; split_bf16x8(wf[nt], whi, wlo);
#pragma unroll
                for (int rt = 0; rt < 3; ++rt) {
                    acc[nt][rt] = __builtin_amdgcn_mfma_f32_16x16x32_bf16(whi, chi[rt], acc[nt][rt], 0, 0, 0);
                    acc[nt][rt] = __builtin_amdgcn_mfma_f32_16x16x32_bf16(whi, clo[rt], acc[nt][rt], 0, 0, 0);
                    acc[nt][rt] = __builtin_amdgcn_mfma_f32_16x16x32_bf16(wlo, chi[rt], acc[nt][rt], 0, 0, 0); } }
        }
        __syncthreads();
#pragma unroll
        for (int nt = 0; nt < 2; ++nt)
#pragma unroll
            for (int rt = 0; rt < 3; ++rt) *(LAS pg8::f32x4*)(red + ((wv * 6 + nt * 3 + rt) * 64 + l) * 4) = acc[nt][rt];
        __syncthreads();
        for (int e = tid; e < 6 * 64; e += NT) { const int tile = e >> 6, ll = e & 63, nt = tile / 3, rt = tile - 3 * nt, r = 16 * rt + (ll & 15), n = n0 + 16 * nt + 4 * (ll >> 4);
            pg8::f32x4 sacc = *(const f32x4g*)(bb + n);
#pragma unroll
            for (int q = 0; q < 8; ++q) sacc += *(const LAS pg8::f32x4*)(red + ((q * 6 + tile) * 64 + ll) * 4);
            if (r <= 32) *(f32x4g*)(outp + (size_t)r * 3072 + n) = sacc; }
    }
}
constexpr int LDS_MISC_OFF = 136 * 1024 - 64;
struct Params { const float* in[25]; float* out; char* ws; int never; int pad; };

__global__ void __launch_bounds__(NT, 2) mega(Params p) {
    extern __shared__ __attribute__((aligned(16))) unsigned char lds_raw[];
    float* lds = (float*)lds_raw;
    cg::grid_group grid = cg::this_grid();
    const float* x = p.in[0]; const float* c = p.in[1]; const float* ctx = p.in[2]; const float* c_ctx = p.in[3];
    const float* ab_w_mod = p.in[4]; const float* ab_b_mod = p.in[5]; const float* ab_w_in = p.in[6];
    const float* ab_pool_w = p.in[7]; const float* ab_pool_scale = p.in[8]; const float* ab_sgu_w = p.in[9]; const float* ab_sgu_b = p.in[10];
    const float* ab_w_out = p.in[11]; const float* ab_ln_g = p.in[12]; const float* ab_ln_b = p.in[13];
    const float* cd_w_mod = p.in[14]; const float* cd_b_mod = p.in[15]; const float* cd_w_in = p.in[16];
    const float* cd_fnet_w = p.in[17]; const float* cd_q_norm = p.in[18]; const float* cd_kv_norm = p.in[19];
    const float* cd_w_q_up = p.in[20]; const float* cd_w_kv_up = p.in[21]; const float* cd_w_out = p.in[22];
    const float* cd_ln_g = p.in[23]; const float* cd_ln_b = p.in[24];
    float* out = p.out; char* ws = p.ws;
    bf16_t* H0 = (bf16_t*)(ws + OFF_A); bf16_t* MIX0 = H0; bf16_t* H1 = H0; bf16_t* Q = H0; bf16_t* KR = (bf16_t*)(ws + OFF_KR);
    bf16_t* Z0 = (bf16_t*)(ws + OFF_B); h16_t* R0 = (h16_t*)(ws + OFF_B); bf16_t* Z1 = (bf16_t*)(ws + OFF_B); h16_t* TEMP = (h16_t*)(ws + OFF_B); h16_t* R0C = (h16_t*)(ws + OFF_R0C); h16_t* X1h = (h16_t*)out;
    bf16_t* KV = (bf16_t*)(ws + OFF_KV); float* DT = (float*)(ws + OFF_KV); float* VN = (float*)(ws + OFF_T1);
    bf16_t* GR = (bf16_t*)(ws + OFF_T1); bf16_t* GI = GR + (size_t)NLAT * 512; bf16_t* MIX1 = (bf16_t*)(ws + OFF_MIX1); bf16_t* SPEC = (bf16_t*)(ws + OFF_T1); bf16_t* FT = (bf16_t*)(ws + OFF_FT); bf16_t* DFT = (bf16_t*)(ws + OFF_DFT);
    float* MOD0 = (float*)(ws + OFF_MOD0); float* MOD1 = (float*)(ws + OFF_MOD1);
    float* ST1 = (float*)(ws + OFF_ST1); float* RQ = (float*)(ws + OFF_RQ); float* RKV = (float*)(ws + OFF_RKV); float* ROPE = (float*)(ws + OFF_ROPE);
    bf16_t* WIN0 = (bf16_t*)(ws + OFF_WIN0); bf16_t* WOUT0 = (bf16_t*)(ws + OFF_WOUT0); bf16_t* WIN1 = (bf16_t*)(ws + OFF_WIN1); bf16_t* WOUT1 = (bf16_t*)(ws + OFF_WOUT1);
    bf16_t* WPOOL = (bf16_t*)(ws + OFF_WPOOL); bf16_t* WSGU = (bf16_t*)(ws + OFF_WSGU); bf16_t* WFN = (bf16_t*)(ws + OFF_DFT + 8 * MiB);   bf16_t* WQ = (bf16_t*)(ws + OFF_WQ); bf16_t* WKV = (bf16_t*)(ws + OFF_WKV);
    PG8_LAS unsigned char* ldsg = (PG8_LAS unsigned char*)lds_raw;
    const int G = gridDim.x, bid = blockIdx.x;

    volatile LAS unsigned* MISC = (volatile LAS unsigned*)((LAS unsigned char*)lds_raw + LDS_MISC_OFF);
    if (threadIdx.x < 16) MISC[threadIdx.x] = 0u;
    __syncthreads();
    XcdBarrier xb = xcd_barrier_post((unsigned*)(ws + OFF_CTL), MISC);
#define GRID_BAR() xcd_barrier(xb)

    ph_mod(lds_raw, c, c_ctx, ab_w_mod, ab_b_mod, cd_w_mod, cd_b_mod, MOD0, MOD1);
    auto prep = [&](const int part, const int pb, const int PG) {
        LAS float* ctab = (LAS float*)((LAS unsigned char*)lds_raw + 135168);
        __syncthreads();
        if (part >= 2 && threadIdx.x < 128) { ctab[threadIdx.x] = cospif((float)threadIdx.x * (1.f / 64.f)); ctab[128 + threadIdx.x] = sinpif((float)threadIdx.x * (1.f / 64.f)); }
        __syncthreads();
        const int wave = __builtin_amdgcn_readfirstlane(threadIdx.x >> 6), lane = threadIdx.x & 63;
        LAS float* scr = (LAS float*)((LAS char*)lds_raw + wave * 16384);
        const int gw = pb * 8 + wave, NGW = PG * 8;
        constexpr int I0 = (DM / 64) * (ABIN / 32), I1 = (DM / 64) * (DM / 32), I2 = (DM / 64) * (CDIN / 32), I3 = I1, I4 = 4 * (128 / 64) * (128 / 32), I5 = (256 / 64) * (768 / 32), I6 = (128 / 64) * (1024 / 32);
        if (part == 0) {
            for (int it = gw; it < I0 + I1 + I4; it += NGW) {
                int r = it;
                if (r < I0) { transpose_item(ab_w_in, DM, ABIN, nullptr, WIN0, DM, scr, r, lane, true); continue; } r -= I0;
                if (r < I1) { transpose_item(ab_w_out, DM, DM, nullptr, WOUT0, DM, scr, r, lane); continue; } r -= I1;
                transpose_item(ab_pool_w + (r >> 3) * 16384, 128, 128, nullptr, WPOOL + (r >> 3) * 16384, 128, scr, r & 7, lane);
            }
            for (int i = pb * NT + threadIdx.x; i < 4 * 16384; i += PG * NT) WSGU[i] = f2bf(ab_sgu_w[i]);
            return;
        }
        if (part & 1) {
            for (int it = gw; it < I2; it += NGW) transpose_item(cd_w_in, DM, CDIN, nullptr, WIN1, DM, scr, it, lane);
            for (int i = pb * NT + threadIdx.x; i < 96 * 1024 / 8; i += PG * NT) ((v4u*)(WIN1 + (size_t)CDIN * DM))[i] = (v4u){0u, 0u, 0u, 0u};
            if (part == 1) { __syncthreads(); return; }
        }
        for (int it = gw; it < I3 + I5 + I6; it += NGW) {
            int r = it;
            if (r < I3) { transpose_item(cd_w_out, DM, DM, nullptr, WOUT1, DM, scr, r, lane); continue; } r -= I3;
            if (r < I5) { transpose_item(cd_w_q_up, 256, 768, cd_q_norm, WQ, 256, scr, r, lane); continue; } r -= I5;
            transpose_item(cd_w_kv_up, 128, 1024, cd_kv_norm, WKV, 256, scr, r, lane);
        }
        for (int i = pb * NT + threadIdx.x; i < 1024 * 16; i += PG * NT) ((v4u*)(WKV + (size_t)(i >> 4) * 256 + 128))[i & 15] = (v4u){0u, 0u, 0u, 0u};
        for (int i = pb * NT + threadIdx.x; i < 2048 * 128; i += PG * NT) {
            const int m = i >> 7, l0 = (i & 127) * 8, grp = m >> 9, k = 2 * (m & 511) + (grp & 1); const bool sn = grp >= 2; float v[8];
#pragma unroll
            for (int j = 0; j < 8; ++j) { const int l = l0 + j; const float a = (float)((k * l) & 2047) * (1.f / 1024.f);
                v[j] = !sn ? cospif(a) : (k == 0 ? ((l & 1) ? -1.f : 1.f) : sinpif(a)); }
            ((v4u*)DFT)[i] = (v4u){pk2(v[0], v[1]), pk2(v[2], v[3]), pk2(v[4], v[5]), pk2(v[6], v[7])};
        }
        {   LAS float* colb = scr;
            for (int it = gw; it < 4 * 512; it += NGW) {
                const int h = it >> 9, n = it & 511;
                LDS_WAIT(); asm volatile("" ::: "memory");
                colb[lane] = cd_fnet_w[(size_t)(h * 128 + lane) * 512 + n]; colb[64 + lane] = cd_fnet_w[(size_t)(h * 128 + 64 + lane) * 512 + n];
                LDS_WAIT(); asm volatile("" ::: "memory");
                float a0 = 0.f, a1 = 0.f, a2 = 0.f, a3 = 0.f;
#pragma unroll 8
                for (int cc = 0; cc < 128; ++cc) { const float wv = colb[cc]; const int p0 = (lane * cc) & 127, p1 = ((64 + lane) * cc) & 127;
                    a0 += ctab[p0] * wv; a1 += ctab[p1] * wv; a2 -= ctab[128 + p0] * wv; a3 -= ctab[128 + p1] * wv; }
                bf16_t* wrow = WFN + (size_t)n * 1024 + h * 128;
                wrow[lane] = f2bf(a0 * (1.f / 512.f)); wrow[64 + lane] = f2bf(a1 * (1.f / 512.f)); wrow[512 + lane] = f2bf(a2 * (1.f / 512.f)); wrow[512 + 64 + lane] = f2bf(a3 * (1.f / 512.f));
                bf16_t* wrow2 = wrow + (size_t)512 * 1024;
                wrow2[lane] = f2bf(a0 * (1.f / 512.f)); wrow2[64 + lane] = f2bf(a1 * (1.f / 512.f)); wrow2[512 + lane] = f2bf(-a2 * (1.f / 512.f)); wrow2[512 + 64 + lane] = f2bf(-a3 * (1.f / 512.f));
            }
        }
        __syncthreads();
    };
    prep(0, bid, G);
    if (p.never) grid.sync();
    GRID_BAR();
    h0_rows(NLAT, NCTX, bid * 8 + (threadIdx.x >> 6), G * 8, x, ctx, MOD0, H0);
    for (int pm = bid; pm < 256; pm += G) {
        h0_rows(pm * 256, 256, threadIdx.x >> 6, 8, x, ctx, MOD0, H0);
        __syncthreads();
        pg8::Gemm g{H0, WIN0, NROW, ABIN, DM, DM, DM, 0}; pg8::PanelOrder10 S{pm};
        pg8::EpiZ0 E{Z0};
        pg8::gemm_phase<pg8::EpiZ0, pg8::PanelOrder10, true, true>(ldsg, g, S, E);
    }
    GRID_BAR();
    unsigned* ctxflag = (unsigned*)(ws + OFF_CTL) + 4096;
    if (G == 256) {
        const int jj = bid & 7, rank = (bid >> 3) * 4 + (jj - 4);
        const int extra = (jj >= 4 && rank < 64) ? 256 + rank : -1;
        {   pg8::Gemm g{H0, WIN0, NROW, ABIN, DM, DM, DM, 0}; pg8::CtxInOrder2 S{bid, extra};
            pg8::EpiZ0 E{Z0};
            pg8::gemm_phase<pg8::EpiZ0, pg8::CtxInOrder2, true, true>(ldsg, g, S, E); }
        asm volatile("s_waitcnt vmcnt(0)" ::: "memory");
        __syncthreads();
        if (threadIdx.x == 0) { __builtin_amdgcn_fence(__ATOMIC_RELEASE, "agent"); asm volatile("s_waitcnt vmcnt(0)" ::: "memory"); (void)xb_add(ctxflag + 64, extra >= 0 ? 2u : 1u); }
        if (jj >= 4 && rank >= 64) prep(1, rank - 64, 64);
        mixp::mixer_phase(lds_raw, Z0, WPOOL, WSGU, ab_pool_scale, ab_sgu_b, MIX0, ctxflag + 64, 320u, (unsigned*)(ws + OFF_CTL));
    } else {
        {   pg8::Gemm g{H0, WIN0, NROW, ABIN, DM, DM, DM, 0}; pg8::CtxInOrder S{G, bid};
            pg8::EpiZ0 E{Z0};
            pg8::gemm_phase<pg8::EpiZ0, pg8::CtxInOrder, true, true>(ldsg, g, S, E); }
        prep(3, bid, G);
        GRID_BAR();
        mixp::mixer_phase(lds_raw, Z0, WPOOL, WSGU, ab_pool_scale, ab_sgu_b, MIX0, nullptr, 0u, nullptr);
    }
    GRID_BAR();
    {   pg8::Gemm g{MIX0, WOUT0, NROW, DM, DM, DM, DM, 0}; pg8::CtxOutOrder S{G, bid};
        pg8::EpiOut0 E{x, ctx, MOD0, X1h, R0C};
        pg8::gemm_phase<pg8::EpiOut0, pg8::CtxOutOrder, true, true>(ldsg, g, S, E); }
    const bool early_ctx = (G == 256);
    if (early_ctx && bid < 128) {
        asm volatile("s_waitcnt vmcnt(0)" ::: "memory");
        __syncthreads();
        if (threadIdx.x == 0) { __builtin_amdgcn_fence(__ATOMIC_RELEASE, "agent"); asm volatile("s_waitcnt vmcnt(0)" ::: "memory"); (void)xb_add(ctxflag, 1u); }
    }
    for (int pm = bid; pm < 256; pm += G) {
        pg8::Gemm g{MIX0, WOUT0, NROW, DM, DM, DM, DM, 0}; pg8::PanelOrder S{pm};
        pg8::EpiOut0 E{x, ctx, MOD0, X1h, R0C};
        pg8::gemm_phase<pg8::EpiOut0, pg8::PanelOrder, true, true>(ldsg, g, S, E);
        ln0_rows(pm * 256, 256, X1h, 2048, ab_ln_g, ab_ln_b, MOD1, ST1, H1);
        __syncthreads();
    }
    if (early_ctx && bid >= 128 && bid < 160) {
        const int pc = bid - 128;
        if (threadIdx.x == 0) { unsigned* bar = (unsigned*)(ws + OFF_CTL); XB_SPIN(xb_ld(ctxflag) < 128u, bar); __builtin_amdgcn_fence(__ATOMIC_ACQUIRE, "agent"); asm volatile("s_waitcnt vmcnt(0)" ::: "memory"); }
        __syncthreads();
        ln0_rows(NLAT + pc * 256, 256, R0C - (size_t)NLAT * DM, DM, ab_ln_g, ab_ln_b, MOD1, ST1, H1);
        asm volatile("s_waitcnt vmcnt(0)" ::: "memory");
        __syncthreads();
        pg8::Gemm g{H1, WIN1, NROW, Z1LD, DM, DM, DM, 0}; pg8::CtxZ1One S{pc};
        pg8::EpiZ1 E{Z1, RQ, RKV, KR, ROPE};
        pg8::gemm_phase<pg8::EpiZ1, pg8::CtxZ1One, true, true>(ldsg, g, S, E);
    }
    if (early_ctx && bid >= 160) prep(2, bid - 160, G - 160);
    GRID_BAR();
    if (!early_ctx) {
        for (int pc = bid; pc < 32; pc += G) ln0_rows(NLAT + pc * 256, 256, R0C - (size_t)NLAT * DM, DM, ab_ln_g, ab_ln_b, MOD1, ST1, H1);
        GRID_BAR(); }
    const int vc = (G % 8 == 0) ? (bid % 8) * (G / 8) + bid / 8 : bid;
    {   pg8::Gemm g{H1, WIN1, NROW, Z1LD, DM, DM, DM, 0}; pg8::Z1Order S; S.init(G, early_ctx ? vc : bid, early_ctx ? 0 : 32);
        pg8::EpiZ1 E{Z1, RQ, RKV, KR, ROPE};
        pg8::gemm_phase<pg8::EpiZ1, pg8::Z1Order, true, true>(ldsg, g, S, E); }
    {   pg8::Gemm g{WIN1, H1, 512, NLAT, DM, DM, DM, 0}; pg8::FoldOrder S{G, vc};
        pg8::EpiFold E{FT, FT + (size_t)512 * NB * 1024};
        pg8::gemm_phase<pg8::EpiFold, pg8::FoldOrder, true, true>(ldsg, g, S, E); }
    GRID_BAR();
    {   pg8::Gemm g{DFT, FT, 2048, 32 * 512, 1024, 1024, NB * 1024, 0}; pg8::DftOrder S; S.init(G, vc);
        pg8::EpiDft E{SPEC};
        pg8::gemm_phase<pg8::EpiDft, pg8::DftOrder, true, true>(ldsg, g, S, E); }
    {   pg8::Gemm g{Z1 + 1280, WKV, NROW, 1024, 128, Z1LD, 256, 0};   pg8::StaticOrder S; S.init(NROW, 1024, G, bid);
        pg8::EpiRowScale E{KV, RKV, 1024, 0};
        pg8::gemm_phase<pg8::EpiRowScale, pg8::StaticOrder, true, true>(ldsg, g, S, E); }
    {   pg8::Gemm g{Z1 + 1024, WQ, NLAT, 768, 256, Z1LD, 256, 0}; pg8::StaticOrder S; S.init(NLAT, 768, G, bid);
        pg8::EpiQ E{Q, RQ, ROPE};
        pg8::gemm_phase<pg8::EpiQ, pg8::StaticOrder, true, true>(ldsg, g, S, E); }
    GRID_BAR();
    {   pg8::Gemm g{SPEC, WFN, NLAT / 2, DM, DM, DM, DM, 0}; pg8::YcOrder S{G, vc};
        pg8::EpiYc E{Z1, MIX1};
        pg8::gemm_phase<pg8::EpiYc, pg8::YcOrder, true, true>(ldsg, g, S, E); }
    {
        const int wv = threadIdx.x >> 6, lane = threadIdx.x & 63;
        for (int o = bid * 8 + wv; o < NB * 512; o += G * 8) {
            const int b = o >> 9, n = o & 511; const size_t row = (size_t)b * 2048 + 1024;
            float av[8], wv8[8]; { const v4u t0 = *(const v4u*)(SPEC + row * DM + 8 * lane); mixp::unpack8(t0, av); const v4u t1 = *(const v4u*)(WFN + (size_t)n * DM + 8 * lane); mixp::unpack8(t1, wv8); }
            float d = 0.f;
#pragma unroll
            for (int i = 0; i < 8; ++i) d += av[i] * wv8[i];
            d = wave_sum(d);
            if (lane == 0) MIX1[row * DM + n] = f2bf(d * pg8::silu_fast(bf2f(Z1[row * Z1LD + 512 + n])));
        }
    }
    att::attn_phase<0>(lds_raw, Q, KV, KR, Z1, MIX1);
    GRID_BAR();
    for (int pm = bid; pm < 256; pm += G) {
        pg8::Gemm g{MIX1, WOUT1, NLAT, DM, DM, DM, DM, 0}; pg8::PanelOrder S{pm};
        pg8::EpiOut1 E{MOD1, X1h, TEMP, ST1, ab_ln_g};
        pg8::gemm_phase<pg8::EpiOut1, pg8::PanelOrder, true, true>(ldsg, g, S, E);
        ln1_rows(pm * 256, 256, TEMP, ab_ln_b, cd_ln_g, cd_ln_b, out);
        __syncthreads();
    }
}


constexpr size_t LDS_BYTES = 136 * 1024;

extern "C" void kernel_launch(void* const* d_in, const int* in_sizes, int n_in, void* d_out, int out_size, void* d_ws, size_t ws_size, hipStream_t stream) {
    static int grid_blocks = 0;
    if (!grid_blocks) {
        int dev = 0, cus = 0, per_cu = 0;
        (void)hipGetDevice(&dev);
        (void)hipDeviceGetAttribute(&cus, hipDeviceAttributeMultiprocessorCount, dev);
        (void)hipFuncSetAttribute((const void*)mega, hipFuncAttributeMaxDynamicSharedMemorySize, (int)LDS_BYTES);
        (void)hipOccupancyMaxActiveBlocksPerMultiprocessor(&per_cu, (const void*)mega, NT, LDS_BYTES);
        if (per_cu < 1) per_cu = 1;
        if (per_cu > 1) per_cu = 1;
        grid_blocks = cus * per_cu;
        grid_blocks -= grid_blocks % 8;
    }
    if (ws_size < 960 * MiB) { fprintf(stderr, "workspace too small: %zu\n", ws_size); return; }
    Params p{};
    for (int i = 0; i < 25; ++i) p.in[i] = (const float*)d_in[i];
    p.out = (float*)d_out; p.ws = (char*)d_ws;
    (void)hipMemsetAsync((char*)d_ws + OFF_CTL, 0, CTL_BYTES, stream);
    void* args[] = {&p};
    hipError_t e = hipLaunchCooperativeKernel((const void*)mega, dim3(grid_blocks), dim3(NT), args, LDS_BYTES, stream);
    if (e != hipSuccess) fprintf(stderr, "cooperative launch failed: %s (grid %d)\n", hipGetErrorString(e), grid_blocks);
}
```

```cpp
#include <hip/hip_runtime.h>
#include <hip/hip_cooperative_groups.h>
namespace cg = cooperative_groups;
#include <stdint.h>
#include <cstdio>

typedef unsigned short bf16_t;
typedef _Float16 h16_t;

#define DI __device__ __forceinline__
DI float bf2f(bf16_t v) { return __uint_as_float(((unsigned)v) << 16); }
DI bf16_t f2bf(float f) { unsigned u = __float_as_uint(f); u += 0x7fffu + ((u >> 16) & 1u); return (bf16_t)(u >> 16); }
DI float silu(float x) { return x / (1.f + expf(-x)); }
DI float wave_sum(float v) {
#pragma unroll
    for (int o = 1; o < 64; o <<= 1) v += __shfl_xor(v, o);
    return v;
}

constexpr int NB = 32, SEQ = 2048, DM = 1024, CTXL = 256;
constexpr int NLAT = NB * SEQ;
constexpr int NCTX = NB * CTXL;
constexpr int NROW = NLAT + NCTX;
constexpr int ABIN = 2560, CDIN = 1952, Z1LD = 2048, Z0LD = 2048;
constexpr float EPS = 1e-6f;
constexpr float ALPHA = 1.41421356237309515f;
constexpr float QSCALE = 0.10206207261596577f * 1.4426950408889634f;

constexpr size_t MiB = 1u << 20;
constexpr size_t OFF_A = 0;
constexpr size_t OFF_KR = 448 * MiB;
constexpr size_t OFF_R0C = 432 * MiB;
constexpr size_t OFF_B = 144 * MiB;
constexpr size_t OFF_ZC1 = 400 * MiB;
constexpr size_t OFF_KV = 504 * MiB;
constexpr size_t OFF_T1 = 648 * MiB;
constexpr size_t OFF_MIX1 = 792 * MiB;
constexpr size_t OFF_FT = 792 * MiB;
constexpr size_t OFF_DFT = 920 * MiB;
constexpr size_t OFF_W = 936 * MiB;
constexpr size_t OFF_WIN0 = OFF_W, OFF_WOUT0 = OFF_W + 5 * MiB, OFF_WIN1 = OFF_W + 7 * MiB, OFF_WOUT1 = OFF_W + 11 * MiB, OFF_WFN = OFF_W + 13 * MiB, OFF_WQ = OFF_W + 14 * MiB, OFF_WKV = OFF_W + 15 * MiB, OFF_WPOOL = OFF_W + 15 * MiB + 512 * 1024, OFF_WSGU = OFF_WPOOL + 128 * 1024;
constexpr size_t OFF_SMALL = 952 * MiB;
constexpr size_t OFF_MOD0 = OFF_SMALL, OFF_MOD1 = OFF_SMALL + 512 * 1024, OFF_COS = OFF_SMALL + 1024 * 1024, OFF_SIN = OFF_COS + 8192,
                 OFF_RQ = OFF_SMALL + 2 * MiB, OFF_RKV = OFF_SMALL + 3 * MiB, OFF_ROPE = OFF_SMALL + 4608 * 1024, OFF_CTL = OFF_SMALL + 5 * MiB, OFF_ST1 = OFF_SMALL + 6 * MiB;
constexpr size_t CTL_BYTES = 64 * 1024;

struct RowInfo { int b, t, L, modrow, base; };
DI RowInfo rowinfo(int row) {
    RowInfo r;
    if (row < NLAT) { r.b = row >> 11; r.t = row & 2047; r.L = SEQ; r.modrow = r.b; r.base = r.b * SEQ; }
    else { int rc = row - NLAT; r.b = rc >> 8; r.t = rc & 255; r.L = CTXL; r.modrow = 32; r.base = NLAT + r.b * CTXL; }
    return r;
}


namespace pg8 {
#define PG8_LAS __attribute__((address_space(3)))
typedef unsigned short bf16_t;
typedef short bf16x8 __attribute__((ext_vector_type(8)));
typedef float f32x4 __attribute__((ext_vector_type(4)));
typedef unsigned u32x4 __attribute__((ext_vector_type(4)));
constexpr int BM = 256, BK = 64, HALF = 128, HTB = HALF * BK * 2  , STAGE_BYTES = 8 * HTB, NXCD = 8, WGM = 8;

__host__ __device__ __forceinline__ int lds_byte(int r, int c) { const int st = (r >> 4) * 2 + (c >> 5), rr = r & 15, cc = c & 31, ob = rr * 64 + cc * 2; return st * 1024 + (ob ^ (((ob >> 9) & 1) << 5)); }
__host__ __device__ __forceinline__ void stage_rc(int b, int& R, int& C) { const int st = b / 1024, sb = b % 1024, swz = sb ^ (((sb >> 9) & 1) << 5); R = (st >> 1) * 16 + swz / 64; C = (st & 1) * 32 + (swz % 64) / 2; }
__host__ __device__ __forceinline__ int perm32(int rho) { const int n = rho >> 4, i = rho & 15; return 8 * (i >> 2) + 4 * n + (i & 3); }

struct Unit { int pm, pn; };
struct Gemm { const bf16_t* A; const bf16_t* Bt; int M, N, K, lda, ldb, pad; };

struct StaticOrder {
    int nM, nN, nwg, G, c;
    __host__ __device__ void init(int M, int N, int G_, int c_) { nM = M / BM; nN = N / BM; nwg = nM * nN; G = G_; c = c_; }
    __host__ __device__ bool next(int i, Unit& u) const {
        const long L = (long)i * G + c; if (L >= nwg) return false;
        int wgid = (int)L; { const int q = nwg / NXCD, r = nwg % NXCD, xcd = wgid % NXCD, off = wgid / NXCD; wgid = (xcd < r ? xcd * (q + 1) : r * (q + 1) + (xcd - r) * q) + off; }
        const int nig = WGM * nN, gid = wgid / nig, fm = gid * WGM, gsz = (nM - fm) < WGM ? (nM - fm) : WGM;
        u.pm = fm + ((wgid % nig) % gsz); u.pn = (wgid % nig) / gsz; return true;
    }
    __device__ __forceinline__ void a_ready(const Unit&) const {}
    __device__ __forceinline__ void done(const Unit&) const {}
    __device__ __forceinline__ size_t offA(const Unit& u, size_t ts) const { return (size_t)u.pm * ts; }
    __device__ __forceinline__ size_t offB(const Unit& u, size_t ts) const { return (size_t)u.pn * ts; }
    DI size_t halfB(size_t h) const { return h; }
};

__device__ __forceinline__ unsigned cvt_pk_bf16(float lo, float hi) { unsigned r; asm volatile("v_cvt_pk_bf16_f32 %0, %1, %2" : "=v"(r) : "v"(lo), "v"(hi)); return r; }
typedef float f32x2 __attribute__((ext_vector_type(2)));
__device__ __forceinline__ f32x2 gelu_pk(f32x2 v) {
    const f32x2 av = __builtin_elementwise_abs(v), d = av * 0.2316418882f + 1.0f;
    f32x2 t; t.x = __builtin_amdgcn_rcpf(d.x); t.y = __builtin_amdgcn_rcpf(d.y);
    f32x2 q = t * 0.5307027145f + (-0.7265760135f); q = q * t + 0.7107068705f; q = q * t + (-0.142248368f); q = q * t + 0.127414796f; q = q * t;
    const f32x2 s = (v * v) * (-0.72134752044f);
    f32x2 e; e.x = __builtin_amdgcn_exp2f(s.x); e.y = __builtin_amdgcn_exp2f(s.y);
    const f32x2 m = v * (q * e), r = v - m;
    f32x2 o; o.x = v.x < 0.f ? m.x : r.x; o.y = v.y < 0.f ? m.y : r.y; return o;
}

template <int ACT  > struct EpiBf16 {
    static constexpr bool PERM = true, AFTER_DRAIN = false; static_assert(ACT == 0 || ACT == 1, "EpiBf16: ACT is 0 (none) or 1 (gelu_pk)");
    bf16_t* O; int ldc; const float* bias; int split_cols; size_t split_stride; float scale0;
    __device__ __forceinline__ void operator()(const f32x4 (&acc)[2][2][4][2], const Unit& u, int wr, int wc, int fr, int fq) const {
        const int row0 = u.pm * BM + wr * 64 + fr; int colt = u.pn * BM; bf16_t* base = O;
        float sc = 1.f; if (split_cols) { const int t = colt / split_cols; base += (size_t)t * split_stride; colt -= t * split_cols; if (t == 0) sc = scale0; }
        const int col0 = colt + wc * 32 + 8 * fq, bcol0 = u.pn * BM + wc * 32 + 8 * fq;
        f32x4 bv[2][2];
#pragma unroll
        for (int bj = 0; bj < 2; ++bj)
#pragma unroll
            for (int n = 0; n < 2; ++n) bv[bj][n] = bias ? *(const f32x4*)(bias + bcol0 + bj * HALF + 4 * n) : (f32x4){0.f, 0.f, 0.f, 0.f};
#pragma unroll
        for (int ai = 0; ai < 2; ++ai)
#pragma unroll
            for (int m = 0; m < 4; ++m) { bf16_t* rowp = base + (size_t)(row0 + ai * HALF + m * 16) * ldc + col0;
#pragma unroll
                for (int bj = 0; bj < 2; ++bj) { f32x4 v0 = acc[ai][bj][m][0] + bv[bj][0], v1 = acc[ai][bj][m][1] + bv[bj][1];
                    if (ACT == 1) { f32x2 a = gelu_pk((f32x2){v0[0], v0[1]}), b = gelu_pk((f32x2){v0[2], v0[3]}), c = gelu_pk((f32x2){v1[0], v1[1]}), d = gelu_pk((f32x2){v1[2], v1[3]});
                        v0 = (f32x4){a.x, a.y, b.x, b.y}; v1 = (f32x4){c.x, c.y, d.x, d.y}; }
                    v0 = v0 * sc; v1 = v1 * sc; u32x4 w; w.x = cvt_pk_bf16(v0[0], v0[1]); w.y = cvt_pk_bf16(v0[2], v0[3]); w.z = cvt_pk_bf16(v1[0], v1[1]); w.w = cvt_pk_bf16(v1[2], v1[3]);
                    *(u32x4*)(rowp + bj * HALF) = w; } }
    }
};

template <class Epi, class Sched, bool ALIGN_EPI = false, bool SP2 = false>
__device__ __forceinline__ void gemm_phase(PG8_LAS unsigned char* lds, const Gemm g, const Sched& S, const Epi& E) {
    int tid_ = threadIdx.x; asm volatile("" : "+v"(tid_));
    const int tid = tid_, wid = __builtin_amdgcn_readfirstlane(tid >> 6), lane = tid & 63, wr = wid >> 2, wc = wid & 3, fr = lane & 15, fq = lane >> 4;
    int K_ = g.K; asm volatile("" : "+s"(K_));
    const int K = K_, nt = K / BK;
    unsigned voffA[2], voffB[2];
#pragma unroll
    for (int i = 0; i < 2; ++i) { int R, C; stage_rc(tid * 16 + i * 8192, R, C); const int Rb = Epi::PERM ? ((R & ~31) + perm32(R & 31)) : R;
        voffA[i] = (unsigned)(R * g.lda + C) * 2u; voffB[i] = (unsigned)(Rb * g.ldb + C) * 2u; }
    const size_t kstep = (size_t)(BK * 2);
    const size_t hstepA = (size_t)HALF * g.lda * 2, hB0 = (size_t)HALF * g.ldb * 2, hstepB = S.halfB(hB0);
    const size_t tstepA = 2 * hstepA, tstepB = 2 * hB0;
    const unsigned ldsw = (unsigned)wid * 1024u;
    const int aoff = lds_byte(wr * 64 + fr, fq * 8), boff = lds_byte(wc * 32 + fr, fq * 8);
#define PG8_SA(b, h) (((b) * 2 + (h)) * HTB)
#define PG8_SB(b, h) ((4 + (b) * 2 + (h)) * HTB)
#define PG8_STAGE(bufoff, gbase, voff) do { _Pragma("unroll") for (int _i = 0; _i < 2; ++_i) \
        __builtin_amdgcn_global_load_lds((const unsigned*)((const char*)(gbase) + (voff)[_i]), (PG8_LAS unsigned*)(lds + (bufoff) + ldsw + _i * 8192), 16, 0, 0); } while (0)
#define PG8_LDA(dst, b, h) do { _Pragma("unroll") for (int m = 0; m < 4; ++m) _Pragma("unroll") for (int k = 0; k < 2; ++k) dst[m][k] = *(const PG8_LAS bf16x8*)(lds + PG8_SA(b, h) + aoff + m * 2048 + k * 1024); } while (0)
#define PG8_LDB(dst, b, h) do { _Pragma("unroll") for (int n = 0; n < 2; ++n) _Pragma("unroll") for (int k = 0; k < 2; ++k) dst[n][k] = *(const PG8_LAS bf16x8*)(lds + PG8_SB(b, h) + boff + n * 2048 + k * 1024); } while (0)
#define PG8_MMA(ai, bj, At, Bt) do { __builtin_amdgcn_s_setprio(1); _Pragma("unroll") for (int m = 0; m < 4; ++m) _Pragma("unroll") for (int n = 0; n < 2; ++n) _Pragma("unroll") for (int k = 0; k < 2; ++k) \
        acc[ai][bj][m][n] = __builtin_amdgcn_mfma_f32_16x16x32_bf16(Bt[n][k], At[m][k], acc[ai][bj][m][n], 0, 0, 0); __builtin_amdgcn_s_setprio(0); } while (0)
#define PG8_WAIT_V(n) asm volatile("s_waitcnt vmcnt(" #n ")" ::: "memory")
#define PG8_WAIT_L(n) asm volatile("s_waitcnt lgkmcnt(" #n ")" ::: "memory")
#define PG8_BAR __builtin_amdgcn_s_barrier()
#define PG8_SCHED __builtin_amdgcn_sched_barrier(0)
    Unit cur, nxt; int ui = 0;
    if (!S.next(0, cur)) return;
    f32x4 acc[2][2][4][2];
#pragma unroll
    for (int a = 0; a < 2; ++a)
#pragma unroll
        for (int b = 0; b < 2; ++b)
#pragma unroll
            for (int m = 0; m < 4; ++m)
#pragma unroll
                for (int n = 0; n < 2; ++n) acc[a][b][m][n] = (f32x4){0.f, 0.f, 0.f, 0.f};
    bf16x8 At[4][2], B0[2][2], B1[2][2];
    const char* cA = (const char*)g.A + S.offA(cur, tstepA); const char* cB = (const char*)g.Bt + S.offB(cur, tstepB);
    S.a_ready(cur);
    if constexpr (SP2) {
        PG8_STAGE(PG8_SB(0, 0), cB, voffB); PG8_STAGE(PG8_SB(0, 1), cB + hstepB, voffB); PG8_STAGE(PG8_SA(0, 0), cA, voffA); PG8_STAGE(PG8_SA(0, 1), cA + hstepA, voffA);
        if (wr == 1) PG8_BAR;
        PG8_WAIT_V(2); PG8_BAR;
        PG8_STAGE(PG8_SB(1, 0), cB + kstep, voffB); PG8_STAGE(PG8_SA(1, 0), cA + kstep, voffA); PG8_STAGE(PG8_SB(1, 1), cB + hstepB + kstep, voffB);
        PG8_WAIT_V(6); PG8_BAR;
    } else {
        PG8_STAGE(PG8_SB(0, 0), cB, voffB); PG8_STAGE(PG8_SA(0, 0), cA, voffA); PG8_STAGE(PG8_SB(0, 1), cB + hstepB, voffB); PG8_STAGE(PG8_SA(0, 1), cA + hstepA, voffA);
        if (wr == 1) PG8_BAR;
        PG8_WAIT_V(4); PG8_BAR;
        PG8_STAGE(PG8_SB(1, 0), cB + kstep, voffB); PG8_STAGE(PG8_SA(1, 0), cA + kstep, voffA); PG8_STAGE(PG8_SB(1, 1), cB + hstepB + kstep, voffB);
        PG8_WAIT_V(6); PG8_BAR;
    }
    for (;;) {
        const bool has_next = S.next(ui + 1, nxt);
        const char* nA = has_next ? (const char*)g.A + S.offA(nxt, tstepA) : cA; const char* nB = has_next ? (const char*)g.Bt + S.offB(nxt, tstepB) : cB;
        for (int t = 0; t < nt; t += 2) {
            const bool last = (t == nt - 2);
            const char* a1 = cA + (size_t)(t + 1) * kstep;
            const char* a2 = last ? nA : cA + (size_t)(t + 2) * kstep; const char* b2 = last ? nB : cB + (size_t)(t + 2) * kstep;
            const char* a3 = a2 + kstep; const char* b3 = b2 + kstep;
            if (last && has_next) S.a_ready(nxt);
            if constexpr (SP2) {
            PG8_LDB(B0, 0, 0); PG8_LDB(B1, 0, 1); PG8_SCHED; PG8_LDA(At, 0, 0); PG8_STAGE(PG8_SA(1, 1), a1 + hstepA, voffA);
            PG8_WAIT_V(8); PG8_WAIT_L(0); PG8_BAR; PG8_MMA(0, 0, At, B0); PG8_MMA(0, 1, At, B1); PG8_BAR; PG8_SCHED;
            PG8_LDA(At, 0, 1); PG8_STAGE(PG8_SB(0, 0), b2, voffB); PG8_STAGE(PG8_SB(0, 1), b2 + hstepB, voffB); PG8_STAGE(PG8_SA(0, 0), a2, voffA);
            PG8_WAIT_V(8); PG8_WAIT_L(0); PG8_BAR; PG8_MMA(1, 0, At, B0); PG8_MMA(1, 1, At, B1); PG8_BAR; PG8_SCHED;
            PG8_LDB(B0, 1, 0); PG8_LDB(B1, 1, 1); PG8_SCHED; PG8_LDA(At, 1, 0); PG8_STAGE(PG8_SA(0, 1), a2 + hstepA, voffA);
            PG8_WAIT_V(8); PG8_WAIT_L(0); PG8_BAR; PG8_MMA(0, 0, At, B0); PG8_MMA(0, 1, At, B1); PG8_BAR; PG8_SCHED;
            PG8_LDA(At, 1, 1); PG8_STAGE(PG8_SB(1, 0), b3, voffB); PG8_STAGE(PG8_SB(1, 1), b3 + hstepB, voffB); PG8_STAGE(PG8_SA(1, 0), a3, voffA);
            PG8_WAIT_V(8); PG8_WAIT_L(0); PG8_BAR; PG8_MMA(1, 0, At, B0); PG8_MMA(1, 1, At, B1); PG8_BAR; PG8_SCHED;
            } else {
            PG8_LDB(B0, 0, 0); PG8_SCHED; PG8_LDA(At, 0, 0); PG8_STAGE(PG8_SA(1, 1), a1 + hstepA, voffA);
            PG8_WAIT_L(8); PG8_BAR; PG8_WAIT_L(0); PG8_MMA(0, 0, At, B0); PG8_BAR; PG8_SCHED;
            PG8_LDB(B1, 0, 1); PG8_STAGE(PG8_SB(0, 0), b2, voffB);
            PG8_BAR; PG8_WAIT_L(0); PG8_MMA(0, 1, At, B1); PG8_BAR;
            PG8_LDA(At, 0, 1); PG8_STAGE(PG8_SA(0, 0), a2, voffA);
            PG8_BAR; PG8_WAIT_L(0); PG8_MMA(1, 0, At, B0); PG8_BAR; PG8_SCHED;
            PG8_STAGE(PG8_SB(0, 1), b2 + hstepB, voffB);
            PG8_WAIT_V(6); PG8_BAR; PG8_MMA(1, 1, At, B1); PG8_BAR;
            PG8_LDB(B0, 1, 0); PG8_SCHED; PG8_LDA(At, 1, 0); PG8_STAGE(PG8_SA(0, 1), a2 + hstepA, voffA);
            PG8_WAIT_L(8); PG8_BAR; PG8_WAIT_L(0); PG8_MMA(0, 0, At, B0); PG8_BAR; PG8_SCHED;
            PG8_LDB(B1, 1, 1); PG8_STAGE(PG8_SB(1, 0), b3, voffB);
            PG8_BAR; PG8_WAIT_L(0); PG8_MMA(0, 1, At, B1); PG8_BAR;
            PG8_LDA(At, 1, 1); PG8_STAGE(PG8_SA(1, 0), a3, voffA);
            PG8_BAR; PG8_WAIT_L(0); PG8_MMA(1, 0, At, B0); PG8_BAR; PG8_SCHED;
            PG8_STAGE(PG8_SB(1, 1), b3 + hstepB, voffB);
            PG8_WAIT_V(6); PG8_BAR; PG8_MMA(1, 1, At, B1); PG8_BAR;
            }
        }
        if constexpr (ALIGN_EPI) { if (wr == 0) PG8_BAR; }
        if constexpr (!Epi::AFTER_DRAIN) { E(acc, cur, wr, wc, fr, fq); S.done(cur); }
        if (!has_next) break;
#pragma unroll
        for (int a = 0; a < 2; ++a)
#pragma unroll
            for (int b = 0; b < 2; ++b)
#pragma unroll
                for (int m = 0; m < 4; ++m)
#pragma unroll
                    for (int n = 0; n < 2; ++n) acc[a][b][m][n] = (f32x4){0.f, 0.f, 0.f, 0.f};
        cur = nxt; cA = nA; cB = nB; ++ui;
        if constexpr (ALIGN_EPI) { if (wr == 1) PG8_BAR; }
    }
    PG8_WAIT_V(0);
    if constexpr (!ALIGN_EPI) { if (wr == 0) PG8_BAR; }
    PG8_BAR;
    if constexpr (Epi::AFTER_DRAIN) { E.fused(acc, cur, wr, wc, fr, fq, lds, wid, lane); S.done(cur); }
#undef PG8_SA
#undef PG8_SB
#undef PG8_STAGE
#undef PG8_LDA
#undef PG8_LDB
#undef PG8_MMA
#undef PG8_WAIT_V
#undef PG8_WAIT_L
#undef PG8_BAR
#undef PG8_SCHED
}
}

namespace pg8 {
typedef _Float16 h16x2 __attribute__((ext_vector_type(2)));
DI unsigned pk_h2(float a, float b) { h16x2 t = {(_Float16)a, (_Float16)b}; return __builtin_bit_cast(unsigned, t); }
DI float silu_fast(float x) { return x * __builtin_amdgcn_rcpf(1.f + __builtin_amdgcn_exp2f(-1.4426950408889634f * x)); }

DI void rope_cs4(float pos, int n, f32x4& cs, f32x4& sn) {
    constexpr float F[8] = {0.15915494309189535f, 0.050329212104487035f, 0.015915494309189534f, 0.0050329212104487035f, 0.0015915494309189534f, 0.00050329212104487035f, 0.00015915494309189535f, 0.000050329212104487035f};
#pragma unroll
    for (int i = 0; i < 4; ++i) { const float r = pos * F[4 * n + i]; cs[i] = __builtin_amdgcn_cosf(r); sn[i] = __builtin_amdgcn_sinf(r); }
}
struct EpiZ0 {
    static constexpr bool PERM = true, AFTER_DRAIN = false;
    bf16_t* Z0;
    DI void operator()(const f32x4 (&acc)[2][2][4][2], const Unit& u, int wr, int wc, int fr, int fq) const {
        asm volatile("" : "+v"(fr), "+v"(fq));
        const int row0 = u.pm * BM + wr * 64 + fr, cw = wc * 32 + 8 * fq;
        const bool ug = u.pn >= 4 && u.pn < 8, sg = u.pn == 2 || u.pn == 3;
        const int colb = u.pn < 4 ? u.pn * BM : ug ? 1024 + 128 * (u.pn - 4) : 1536 + BM * (u.pn - 8);
#pragma unroll
        for (int ai = 0; ai < 2; ++ai)
#pragma unroll
            for (int m = 0; m < 4; ++m) {
                bf16_t* orow = Z0 + (size_t)(row0 + ai * HALF + m * 16) * Z0LD + colb + cw;
                if (ug) {
                    const f32x4 u0 = acc[ai][0][m][0], u1 = acc[ai][0][m][1], g0 = acc[ai][1][m][0], g1 = acc[ai][1][m][1];
                    u32x4 w; w.x = cvt_pk_bf16(u0[0] * silu_fast(g0[0]), u0[1] * silu_fast(g0[1])); w.y = cvt_pk_bf16(u0[2] * silu_fast(g0[2]), u0[3] * silu_fast(g0[3]));
                    w.z = cvt_pk_bf16(u1[0] * silu_fast(g1[0]), u1[1] * silu_fast(g1[1])); w.w = cvt_pk_bf16(u1[2] * silu_fast(g1[2]), u1[3] * silu_fast(g1[3]));
                    *(u32x4*)orow = w;
                } else {
#pragma unroll
                    for (int bj = 0; bj < 2; ++bj) { f32x4 v0 = acc[ai][bj][m][0], v1 = acc[ai][bj][m][1];
                        if (sg) {
#pragma unroll
                            for (int i = 0; i < 4; ++i) { v0[i] = silu_fast(v0[i]); v1[i] = silu_fast(v1[i]); } }
                        u32x4 w; w.x = cvt_pk_bf16(v0[0], v0[1]); w.y = cvt_pk_bf16(v0[2], v0[3]); w.z = cvt_pk_bf16(v1[0], v1[1]); w.w = cvt_pk_bf16(v1[2], v1[3]);
                        *(u32x4*)(orow + bj * HALF) = w; }
                }
            }
    }
};
struct EpiOut0 {
    static constexpr bool PERM = true, AFTER_DRAIN = false;
    const float* x; const float* ctx; const float* MOD0; h16_t* R0; h16_t* R0C;
    DI void operator()(const f32x4 (&acc)[2][2][4][2], const Unit& u, int wr, int wc, int fr, int fq) const {
        asm volatile("" : "+v"(fr), "+v"(fq));
        const int row0 = u.pm * BM + wr * 64 + fr, col0 = u.pn * BM + wc * 32 + 8 * fq;
        const bool lat = u.pm < 256;
        const float* gate = MOD0 + (lat ? (u.pm >> 3) : 32) * 3072 + 2048 + col0;
        const float* xb = (lat ? x + (size_t)row0 * DM : ctx + (size_t)(row0 - NLAT) * DM) + col0;
        h16_t* ob = (lat ? R0 + (size_t)row0 * 2048 : R0C + (size_t)(row0 - NLAT) * DM) + col0; const size_t os = lat ? 2048 : DM;
        f32x4 gv[2][2];
#pragma unroll
        for (int bj = 0; bj < 2; ++bj)
#pragma unroll
            for (int n = 0; n < 2; ++n) gv[bj][n] = *(const f32x4*)(gate + bj * HALF + 4 * n);
        f32x4 xa[2][2][2], xc[2][2][2];
#define EO0_LOAD(X, bt) do { _Pragma("unroll") for (int mm = 0; mm < 2; ++mm) _Pragma("unroll") for (int bj = 0; bj < 2; ++bj) _Pragma("unroll") for (int n = 0; n < 2; ++n) \
            X[mm][bj][n] = *(const f32x4*)(xb + (size_t)(((bt) >> 1) * HALF + (((bt) & 1) * 2 + mm) * 16) * DM + bj * HALF + 4 * n); } while (0)
#define EO0_STORE(X, bt) do { _Pragma("unroll") for (int mm = 0; mm < 2; ++mm) _Pragma("unroll") for (int bj = 0; bj < 2; ++bj) { const int ai_ = (bt) >> 1, m_ = ((bt) & 1) * 2 + mm; \
            const f32x4 v0 = X[mm][bj][0] * ALPHA + gv[bj][0] * acc[ai_][bj][m_][0], v1 = X[mm][bj][1] * ALPHA + gv[bj][1] * acc[ai_][bj][m_][1]; \
            u32x4 w; w.x = pk_h2(v0[0], v0[1]); w.y = pk_h2(v0[2], v0[3]); w.z = pk_h2(v1[0], v1[1]); w.w = pk_h2(v1[2], v1[3]); \
            *(u32x4*)(ob + (size_t)(ai_ * HALF + m_ * 16) * os + bj * HALF) = w; } } while (0)
        EO0_LOAD(xa, 0); EO0_LOAD(xc, 1);
        EO0_STORE(xa, 0); EO0_LOAD(xa, 2);
        EO0_STORE(xc, 1); EO0_LOAD(xc, 3);
        EO0_STORE(xa, 2); EO0_STORE(xc, 3);
#undef EO0_LOAD
#undef EO0_STORE
    }
};
struct EpiRowScale {
    static constexpr bool PERM = true, AFTER_DRAIN = false;
    bf16_t* O; const float* rs; int ldc; int pad;
    DI void operator()(const f32x4 (&acc)[2][2][4][2], const Unit& u, int wr, int wc, int fr, int fq) const {
        asm volatile("" : "+v"(fr), "+v"(fq));
        const int row0 = u.pm * BM + wr * 64 + fr, col0 = u.pn * BM + wc * 32 + 8 * fq;
        f32x4 pq[2][4];
#pragma unroll
        for (int ai = 0; ai < 2; ++ai)
#pragma unroll
            for (int m = 0; m < 4; ++m) pq[ai][m] = *(const f32x4*)(rs + (size_t)(row0 + ai * HALF + m * 16) * 4);
#pragma unroll
        for (int ai = 0; ai < 2; ++ai)
#pragma unroll
            for (int m = 0; m < 4; ++m) {
                const int row = row0 + ai * HALF + m * 16; const f32x4 p4 = pq[ai][m];
                const float sc = __builtin_amdgcn_rsqf(((p4[0] + p4[1]) + (p4[2] + p4[3])) * (1.f / 128.f) + EPS);
                bf16_t* orow = O + (size_t)row * ldc + col0;
#pragma unroll
                for (int bj = 0; bj < 2; ++bj) { const f32x4 v0 = acc[ai][bj][m][0] * sc, v1 = acc[ai][bj][m][1] * sc;
                    u32x4 w; w.x = cvt_pk_bf16(v0[0], v0[1]); w.y = cvt_pk_bf16(v0[2], v0[3]); w.z = cvt_pk_bf16(v1[0], v1[1]); w.w = cvt_pk_bf16(v1[2], v1[3]);
                    *(u32x4*)(orow + bj * HALF) = w; }
            }
    }
};
struct EpiQ {
    static constexpr bool PERM = true, AFTER_DRAIN = false;
    bf16_t* Q; const float* RQ; const float* ROPE;
    DI void operator()(const f32x4 (&acc)[2][2][4][2], const Unit& u, int wr, int wc, int fr, int fq) const {
        asm volatile("" : "+v"(fr), "+v"(fq));
        const int row0 = u.pm * BM + wr * 64 + fr, col0 = u.pn * BM + wc * 32 + 8 * fq;
        const bool odd = (fq & 1) != 0;
        float scv[2][4];
        {   f32x4 pqa[2][4];
#pragma unroll
            for (int ai = 0; ai < 2; ++ai)
#pragma unroll
                for (int m = 0; m < 4; ++m) pqa[ai][m] = *(const f32x4*)(RQ + (size_t)(row0 + ai * HALF + m * 16) * 4);
#pragma unroll
            for (int ai = 0; ai < 2; ++ai)
#pragma unroll
                for (int m = 0; m < 4; ++m) scv[ai][m] = __builtin_amdgcn_rsqf(((pqa[ai][m][0] + pqa[ai][m][1]) + (pqa[ai][m][2] + pqa[ai][m][3])) * (1.f / 256.f) + EPS) * QSCALE; }
#pragma unroll
        for (int ai = 0; ai < 2; ++ai)
#pragma unroll
            for (int m = 0; m < 4; ++m) {
                const int row = row0 + ai * HALF + m * 16; const float sc = scv[ai][m]; const int t = row & 2047;
                const float pos = (float)(fq < 2 ? (t >> 6) : (t & 63));
                bf16_t* orow = Q + (size_t)row * 768 + col0;
#pragma unroll
                for (int bj = 0; bj < 2; ++bj) {
                    f32x4 v[2] = {acc[ai][bj][m][0] * sc, acc[ai][bj][m][1] * sc};
                    const int g32 = 8 * u.pn + 4 * bj + wc;
                    if (g32 % 3 == 2) {
#pragma unroll
                        for (int n = 0; n < 2; ++n) {
                            f32x4 cs, sn; rope_cs4(pos, n, cs, sn);
                            f32x4 oth;
#pragma unroll
                            for (int i = 0; i < 4; ++i) oth[i] = __shfl_xor(v[n][i], 16);
                            v[n] = odd ? (oth * sn + v[n] * cs) : (v[n] * cs - oth * sn);
                        }
                    }
                    u32x4 w; w.x = cvt_pk_bf16(v[0][0], v[0][1]); w.y = cvt_pk_bf16(v[0][2], v[0][3]); w.z = cvt_pk_bf16(v[1][0], v[1][1]); w.w = cvt_pk_bf16(v[1][2], v[1][3]);
                    *(u32x4*)(orow + bj * HALF) = w; }
                asm volatile("" ::: "memory");
            }
    }
};
struct EpiYc {
    static constexpr bool PERM = true, AFTER_DRAIN = false;
    const bf16_t* Z1; bf16_t* MIX1;
    DI void operator()(const f32x4 (&acc)[2][2][4][2], const Unit& u, int wr, int wc, int fr, int fq) const {
        asm volatile("" : "+v"(fr), "+v"(fq));
        const int b = u.pm >> 2, k0 = (u.pm & 3) * BM + wr * 64 + fr, col0 = (u.pn & 1) * BM + wc * 32 + 8 * fq;
        const bool mir = u.pn >= 2;
        u32x4 ga[4][2], gc[4][2];
#define EYC_ROW(ai_, m_) ((size_t)(mir ? b * 2048 + 2048 - (k0 + (ai_) * HALF + (m_) * 16) : b * 2048 + (k0 + (ai_) * HALF + (m_) * 16)))
#define EYC_LOAD(X, ai_) do { _Pragma("unroll") for (int m = 0; m < 4; ++m) _Pragma("unroll") for (int bj = 0; bj < 2; ++bj) X[m][bj] = *(const u32x4*)(Z1 + EYC_ROW(ai_, m) * Z1LD + 512 + col0 + bj * HALF); } while (0)
#define EYC_STORE(X, ai_) do { _Pragma("unroll") for (int m = 0; m < 4; ++m) _Pragma("unroll") for (int bj = 0; bj < 2; ++bj) { const u32x4 gw = X[m][bj]; float gt[8]; \
            _Pragma("unroll") for (int i = 0; i < 4; ++i) { gt[2 * i] = __uint_as_float(gw[i] << 16); gt[2 * i + 1] = __uint_as_float(gw[i] & 0xffff0000u); } \
            const f32x4 a0 = acc[ai_][bj][m][0], a1 = acc[ai_][bj][m][1]; \
            u32x4 w; w.x = cvt_pk_bf16(a0[0] * silu_fast(gt[0]), a0[1] * silu_fast(gt[1])); w.y = cvt_pk_bf16(a0[2] * silu_fast(gt[2]), a0[3] * silu_fast(gt[3])); \
            w.z = cvt_pk_bf16(a1[0] * silu_fast(gt[4]), a1[1] * silu_fast(gt[5])); w.w = cvt_pk_bf16(a1[2] * silu_fast(gt[6]), a1[3] * silu_fast(gt[7])); \
            if (!(mir && (k0 + (ai_) * HALF + m * 16) == 0)) *(u32x4*)(MIX1 + EYC_ROW(ai_, m) * DM + col0 + bj * HALF) = w; } } while (0)
        EYC_LOAD(ga, 0); EYC_LOAD(gc, 1);
        EYC_STORE(ga, 0); EYC_STORE(gc, 1);
#undef EYC_ROW
#undef EYC_LOAD
#undef EYC_STORE
    }
};
struct YcOrder {
    int G, c;
    DI bool next(int i, Unit& u) const { const int L = i * G + c; if (L >= 512) return false; u.pm = L >> 2; u.pn = L & 3; return true; }
    DI void a_ready(const Unit&) const {}
    DI void done(const Unit&) const {}
    DI size_t offA(const Unit& u, size_t) const { return ((size_t)((u.pm >> 2) * 2048 + (u.pm & 3) * 256) * DM) * 2; }
    DI size_t offB(const Unit& u, size_t ts) const { return (size_t)u.pn * ts; }
    DI size_t halfB(size_t h) const { return h; }
};
struct Z1Order {
    int G, c, nctx;
    DI void init(int G_, int c_, int nctx_) { G = G_; c = c_; nctx = nctx_; }
    DI bool next(int i, Unit& u) const { const int L = i * G + c; if (L < 1536) { const int q = L / 6; u.pm = q; u.pn = 2 + (L - 6 * q); return true; } if (L < 1536 + nctx) { u.pm = 256 + (L - 1536); u.pn = 5; return true; } return false; }
    DI void a_ready(const Unit&) const {}
    DI void done(const Unit&) const {}
    DI size_t offA(const Unit& u, size_t ts) const { return (size_t)u.pm * ts; }
    DI size_t offB(const Unit& u, size_t ts) const { return (size_t)u.pn * ts; }
    DI size_t halfB(size_t h) const { return h; }
};
struct CtxInOrder2 {
    int first, extra;
    DI bool next(int i, Unit& u) const { const int L = i == 0 ? first : extra; if (i >= 2 || L < 0) return false; const int q = L / 10; u.pm = 256 + q; u.pn = L - 10 * q; return true; }
    DI void a_ready(const Unit&) const {}
    DI void done(const Unit&) const {}
    DI size_t offA(const Unit& u, size_t ts) const { return (size_t)u.pm * ts; }
    DI size_t offB(const Unit& u, size_t ts) const { return (size_t)u.pn * ts; }
    DI size_t halfB(size_t h) const { return h; }
};
struct CtxZ1One {
    int pc;
    DI bool next(int i, Unit& u) const { if (i >= 1) return false; u.pm = 256 + pc; u.pn = 5; return true; }
    DI void a_ready(const Unit&) const {}
    DI void done(const Unit&) const {}
    DI size_t offA(const Unit& u, size_t ts) const { return (size_t)u.pm * ts; }
    DI size_t offB(const Unit& u, size_t ts) const { return (size_t)u.pn * ts; }
    DI size_t halfB(size_t h) const { return h; }
};
struct PanelOrder {
    int pm;
    DI bool next(int i, Unit& u) const { if (i >= 4) return false; u.pm = pm; u.pn = (i + pm) & 3; return true; }
    DI void a_ready(const Unit&) const {}
    DI void done(const Unit&) const {}
    DI size_t offA(const Unit& u, size_t ts) const { return (size_t)u.pm * ts; }
    DI size_t offB(const Unit& u, size_t ts) const { return (size_t)u.pn * ts; }
    DI size_t halfB(size_t h) const { return h; }
};
struct PanelOrder10 {
    int pm;
    DI bool next(int i, Unit& u) const { if (i >= 10) return false; u.pm = pm; u.pn = (i + pm) % 10; return true; }
    DI void a_ready(const Unit&) const {}
    DI void done(const Unit&) const {}
    DI size_t offA(const Unit& u, size_t ts) const { return (size_t)u.pm * ts; }
    DI size_t offB(const Unit& u, size_t ts) const { return (size_t)u.pn * ts; }
    DI size_t halfB(size_t h) const { return h; }
};
struct CtxInOrder {
    int G, c;
    DI bool next(int i, Unit& u) const { const int L = i * G + c; if (L >= 320) return false; const int q = L / 10; u.pm = 256 + q; u.pn = L - 10 * q; return true; }
    DI void a_ready(const Unit&) const {}
    DI void done(const Unit&) const {}
    DI size_t offA(const Unit& u, size_t ts) const { return (size_t)u.pm * ts; }
    DI size_t offB(const Unit& u, size_t ts) const { return (size_t)u.pn * ts; }
    DI size_t halfB(size_t h) const { return h; }
};
struct CtxOutOrder {
    int G, c;
    DI bool next(int i, Unit& u) const { const int L = i * G + c; if (L >= 128) return false; u.pm = 256 + (L >> 2); u.pn = L & 3; return true; }
    DI void a_ready(const Unit&) const {}
    DI void done(const Unit&) const {}
    DI size_t offA(const Unit& u, size_t ts) const { return (size_t)u.pm * ts; }
    DI size_t offB(const Unit& u, size_t ts) const { return (size_t)u.pn * ts; }
    DI size_t halfB(size_t h) const { return h; }
};
struct EpiZ1 {
    static constexpr bool PERM = true, AFTER_DRAIN = false;
    bf16_t* Z1; float* RQP; float* RKVP; bf16_t* KR; const float* ROPE;
    DI void operator()(const f32x4 (&acc)[2][2][4][2], const Unit& u, int wr, int wc, int fr, int fq) const {
        asm volatile("" : "+v"(fr), "+v"(fq));
        const int row0 = u.pm * BM + wr * 64 + fr, col0 = u.pn * BM + wc * 32 + 8 * fq;
        const bool odd = (fq & 1) != 0;
#pragma unroll
        for (int ai = 0; ai < 2; ++ai)
#pragma unroll
            for (int m = 0; m < 4; ++m) {
                const int row = row0 + ai * HALF + m * 16;
                bf16_t* orow = Z1 + (size_t)row * Z1LD + col0;
#pragma unroll
                for (int bj = 0; bj < 2; ++bj) { const f32x4 v0 = acc[ai][bj][m][0], v1 = acc[ai][bj][m][1];
                    u32x4 w; w.x = cvt_pk_bf16(v0[0], v0[1]); w.y = cvt_pk_bf16(v0[2], v0[3]); w.z = cvt_pk_bf16(v1[0], v1[1]); w.w = cvt_pk_bf16(v1[2], v1[3]);
                    *(u32x4*)(orow + bj * HALF) = w; }
                if (u.pn == 4 || u.pn == 5) {
                    float ss = 0.f;
#pragma unroll
                    for (int bj = 0; bj < 2; ++bj) if (u.pn == 4 || bj == 0) { const f32x4 v0 = acc[ai][bj][m][0], v1 = acc[ai][bj][m][1];
                        ss += (v0[0] * v0[0] + v0[1] * v0[1]) + (v0[2] * v0[2] + v0[3] * v0[3]) + (v1[0] * v1[0] + v1[1] * v1[1]) + (v1[2] * v1[2] + v1[3] * v1[3]); }
                    ss += __shfl_xor(ss, 16); ss += __shfl_xor(ss, 32);
                    if (fq == 0) { if (u.pn == 4) RQP[(size_t)row * 4 + wc] = ss; else RKVP[(size_t)row * 4 + wc] = ss; }
                    if (u.pn == 5 && wc == 0) {
                        f32x4 v[2] = {acc[ai][1][m][0], acc[ai][1][m][1]};
                        if (u.pm < 256) { const int t = row & 2047; const float pos = (float)(fq < 2 ? (t >> 6) : (t & 63));
#pragma unroll
                            for (int n = 0; n < 2; ++n) {
                                f32x4 cs, sn; rope_cs4(pos, n, cs, sn);
                                f32x4 oth;
#pragma unroll
                                for (int i = 0; i < 4; ++i) oth[i] = __shfl_xor(v[n][i], 16);
                                v[n] = odd ? (oth * sn + v[n] * cs) : (v[n] * cs - oth * sn); } }
                        u32x4 w; w.x = cvt_pk_bf16(v[0][0], v[0][1]); w.y = cvt_pk_bf16(v[0][2], v[0][3]); w.z = cvt_pk_bf16(v[1][0], v[1][1]); w.w = cvt_pk_bf16(v[1][2], v[1][3]);
                        *(u32x4*)(KR + (size_t)row * 32 + 8 * fq) = w; }
                }
                if (m & 1) asm volatile("" ::: "memory");
            }
    }
};
struct EpiOut1 {
    static constexpr bool PERM = true, AFTER_DRAIN = false;
    const float* MOD1; const h16_t* R0; h16_t* T; const float* ST1; const float* g;
    DI void operator()(const f32x4 (&acc)[2][2][4][2], const Unit& u, int wr, int wc, int fr, int fq) const {
        asm volatile("" : "+v"(fr), "+v"(fq));
        typedef _Float16 h16x8 __attribute__((ext_vector_type(8)));
        typedef float f32x2 __attribute__((ext_vector_type(2)));
        const int row0 = u.pm * BM + wr * 64 + fr, col0 = u.pn * BM + wc * 32 + 8 * fq;
        const float* gate = MOD1 + (u.pm >> 3) * 3072 + 2048 + col0;
        const h16_t* xb = R0 + (size_t)row0 * 2048 + col0; h16_t* ob = T + (size_t)row0 * DM + col0; const float* stp = ST1 + 2 * (size_t)row0;
        f32x4 gv[2][2], gA[2][2];
#pragma unroll
        for (int bj = 0; bj < 2; ++bj)
#pragma unroll
            for (int n = 0; n < 2; ++n) { gv[bj][n] = *(const f32x4*)(gate + bj * HALF + 4 * n); gA[bj][n] = *(const f32x4*)(g + col0 + bj * HALF + 4 * n) * ALPHA; }
        h16x8 xa[2][2], xc[2][2]; f32x2 sa[2], sc[2];
#define EO1_LOAD(X, S, bt) do { _Pragma("unroll") for (int mm = 0; mm < 2; ++mm) { const int r_ = ((bt) >> 1) * HALF + (((bt) & 1) * 2 + mm) * 16; S[mm] = *(const f32x2*)(stp + 2 * r_); \
            _Pragma("unroll") for (int bj = 0; bj < 2; ++bj) X[mm][bj] = *(const h16x8*)(xb + (size_t)r_ * 2048 + bj * HALF); } } while (0)
#define EO1_STORE(X, S, bt) do { _Pragma("unroll") for (int mm = 0; mm < 2; ++mm) { const int ai_ = (bt) >> 1, m_ = ((bt) & 1) * 2 + mm; const float mu_ = S[mm][0], rs_ = S[mm][1]; \
            _Pragma("unroll") for (int bj = 0; bj < 2; ++bj) { const h16x8 xv = X[mm][bj]; \
            const f32x4 x0 = {((float)xv[0] - mu_) * rs_, ((float)xv[1] - mu_) * rs_, ((float)xv[2] - mu_) * rs_, ((float)xv[3] - mu_) * rs_}, x1 = {((float)xv[4] - mu_) * rs_, ((float)xv[5] - mu_) * rs_, ((float)xv[6] - mu_) * rs_, ((float)xv[7] - mu_) * rs_}; \
            const f32x4 v0 = x0 * gA[bj][0] + gv[bj][0] * acc[ai_][bj][m_][0], v1 = x1 * gA[bj][1] + gv[bj][1] * acc[ai_][bj][m_][1]; \
            u32x4 w; w.x = pk_h2(v0[0], v0[1]); w.y = pk_h2(v0[2], v0[3]); w.z = pk_h2(v1[0], v1[1]); w.w = pk_h2(v1[2], v1[3]); \
            *(u32x4*)(ob + (size_t)(ai_ * HALF + m_ * 16) * DM + bj * HALF) = w; } } } while (0)
        EO1_LOAD(xa, sa, 0); EO1_LOAD(xc, sc, 1);
        EO1_STORE(xa, sa, 0); EO1_LOAD(xa, sa, 2);
        EO1_STORE(xc, sc, 1); EO1_LOAD(xc, sc, 3);
        EO1_STORE(xa, sa, 2); EO1_STORE(xc, sc, 3);
#undef EO1_LOAD
#undef EO1_STORE
    }
};
struct FoldOrder {
    int G, c;
    DI bool next(int i, Unit& u) const { const int L = i * G + c; if (L >= 512) return false; u.pm = L & 1; u.pn = L >> 1; return true; }
    DI void a_ready(const Unit&) const {}
    DI void done(const Unit&) const {}
    DI size_t offA(const Unit& u, size_t ts) const { return (size_t)u.pm * ts; }
    DI size_t offB(const Unit& u, size_t) const { return ((size_t)((u.pn >> 3) * 2048 + (u.pn & 7) * 128) * DM) * 2; }
    DI size_t halfB(size_t) const { return (size_t)1024 * DM * 2; }
};
struct EpiFold {
    static constexpr bool PERM = true, AFTER_DRAIN = false;
    bf16_t* GE; bf16_t* GO;
    DI void operator()(const f32x4 (&acc)[2][2][4][2], const Unit& u, int wr, int wc, int fr, int fq) const {
        asm volatile("" : "+v"(fr), "+v"(fq));
        const int ch0 = u.pm * BM + wr * 64 + fr; const size_t tok0 = (size_t)(u.pn >> 3) * 1024 + (u.pn & 7) * 128 + wc * 32 + 8 * fq;
#pragma unroll
        for (int ai = 0; ai < 2; ++ai)
#pragma unroll
            for (int m = 0; m < 4; ++m) {
                const size_t off = (size_t)(ch0 + ai * HALF + m * 16) * (NB * 1024) + tok0;
                const f32x4 e0 = acc[ai][0][m][0] + acc[ai][1][m][0], e1 = acc[ai][0][m][1] + acc[ai][1][m][1], o0 = acc[ai][0][m][0] - acc[ai][1][m][0], o1 = acc[ai][0][m][1] - acc[ai][1][m][1];
                u32x4 w; w.x = cvt_pk_bf16(e0[0], e0[1]); w.y = cvt_pk_bf16(e0[2], e0[3]); w.z = cvt_pk_bf16(e1[0], e1[1]); w.w = cvt_pk_bf16(e1[2], e1[3]);
                *(u32x4*)(GE + off) = w;
                w.x = cvt_pk_bf16(o0[0], o0[1]); w.y = cvt_pk_bf16(o0[2], o0[3]); w.z = cvt_pk_bf16(o1[0], o1[1]); w.w = cvt_pk_bf16(o1[2], o1[3]);
                *(u32x4*)(GO + off) = w;
            }
    }
};
struct EpiDft {
    static constexpr bool PERM = true, AFTER_DRAIN = false;
    bf16_t* SPEC;
    DI void operator()(const f32x4 (&acc)[2][2][4][2], const Unit& u, int wr, int wc, int fr, int fq) const {
        asm volatile("" : "+v"(fr), "+v"(fq));
        const int m0 = u.pm * BM + wr * 64 + fr, b = u.pn >> 1, part = u.pm >> 2, par = (u.pm >> 1) & 1, col0 = part * 512 + (u.pn & 1) * 256 + wc * 32 + 8 * fq;
        bf16_t* base = SPEC + (size_t)b * 2048 * DM + col0;
#pragma unroll
        for (int ai = 0; ai < 2; ++ai)
#pragma unroll
            for (int m = 0; m < 4; ++m) {
                const int k = 2 * ((m0 + ai * HALF + m * 16) & 511) + par;
#pragma unroll
                for (int bj = 0; bj < 2; ++bj) { const f32x4 v0 = acc[ai][bj][m][0], v1 = acc[ai][bj][m][1];
                    u32x4 w; w.x = cvt_pk_bf16(v0[0], v0[1]); w.y = cvt_pk_bf16(v0[2], v0[3]); w.z = cvt_pk_bf16(v1[0], v1[1]); w.w = cvt_pk_bf16(v1[2], v1[3]);
                    if (part == 0 || k) *(u32x4*)(base + (size_t)k * DM + bj * HALF) = w;
                    else {
                        *(u32x4*)(base - 512 + (size_t)1024 * DM + bj * HALF) = w;
                        const u32x4 z = {0u, 0u, 0u, 0u};
                        *(u32x4*)(base + bj * HALF) = z;
                    }
                }
            }
    }
};
struct DftOrder {
    int G, c;
    DI void init(int G_, int c_) { G = G_; c = c_; }
    DI bool next(int i, Unit& u) const { const int L = i * G + c; if (L >= 512) return false; u.pm = (L & 15) >> 1; u.pn = ((L >> 4) << 1) | (L & 1); return true; }
    DI void a_ready(const Unit&) const {}
    DI void done(const Unit&) const {}
    DI size_t offA(const Unit& u, size_t ts) const { return (size_t)u.pm * ts; }
    DI size_t offB(const Unit& u, size_t) const { return ((size_t)((u.pm >> 1) & 1) * 512 * (NB * 1024) + (size_t)(u.pn & 1) * 256 * (NB * 1024) + (size_t)(u.pn >> 1) * 1024) * 2; }
    DI size_t halfB(size_t h) const { return h; }
};
}

#define LAS __attribute__((address_space(3)))
#define GAS __attribute__((address_space(1)))
typedef unsigned v4u __attribute__((ext_vector_type(4)));
typedef float f32x4g __attribute__((ext_vector_type(4)));
DI unsigned pk2(float lo, float hi) { return (unsigned)f2bf(lo) | ((unsigned)f2bf(hi) << 16); }
#define LDS_WAIT() asm volatile("s_waitcnt lgkmcnt(0)" ::: "memory")

DI int win0_row(int n0) { return n0 < 1024 ? n0 : n0 < 1536 ? 1024 + 256 * ((n0 - 1024) >> 7) + ((n0 - 1024) & 127) : n0 < 2048 ? 2048 + (n0 - 1536) : 1024 + 256 * ((n0 - 2048) >> 7) + 128 + ((n0 - 2048) & 127); }
DI void transpose_item(const float* W, int K, int N, const float* kscale, bf16_t* WT, int ldwt, LAS float* scr, int item, int lane, bool remap0 = false) {
    const int nblk = N / 32, kb = item / nblk, nb = item % nblk, k0 = 64 * kb, n0 = 32 * nb; const int r0 = remap0 ? win0_row(n0) : n0;
    float tv[32];
#pragma unroll
    for (int i = 0; i < 32; ++i) tv[i] = W[(size_t)(k0 + 2 * i + (lane >> 5)) * N + n0 + (lane & 31)];
    if (kscale) {
#pragma unroll
        for (int i = 0; i < 32; ++i) tv[i] *= kscale[k0 + 2 * i + (lane >> 5)]; }
#pragma unroll
    for (int i = 0; i < 32; ++i) scr[(2 * i + (lane >> 5)) * 33 + (lane & 31)] = tv[i];
    LDS_WAIT(); asm volatile("" ::: "memory");
    const int c = lane & 7;
#pragma unroll
    for (int j = 0; j < 4; ++j) { const int n = (lane >> 3) + 8 * j; const LAS float* sp = scr + (8 * c) * 33 + n;
        v4u o; o.x = pk2(sp[0 * 33], sp[1 * 33]); o.y = pk2(sp[2 * 33], sp[3 * 33]); o.z = pk2(sp[4 * 33], sp[5 * 33]); o.w = pk2(sp[6 * 33], sp[7 * 33]);
        *(v4u*)(WT + (size_t)(r0 + n) * ldwt + k0 + 8 * c) = o; }
    LDS_WAIT(); asm volatile("" ::: "memory");
}

constexpr int NT = 512;

namespace att {
typedef short bf16x8 __attribute__((ext_vector_type(8)));
typedef short s16x4 __attribute__((ext_vector_type(4)));
typedef float f32x16 __attribute__((ext_vector_type(16)));
typedef __bf16 bf16x2_t __attribute__((ext_vector_type(2)));
typedef float f32x2_t __attribute__((ext_vector_type(2)));
constexpr int KSTR = 208, VSTR = 192, KBUF = 64 * KSTR, BUF = KBUF + 64 * VSTR;
constexpr int OFF_WS = 2 * BUF, OFF_OST = OFF_WS + 8 * 256, LDS_TOTAL = OFF_OST + 8 * 4096;
constexpr float THR = 8.f;
DI int crow(int r, int hi) { return (r & 3) + 8 * (r >> 2) + 4 * hi; }
DI unsigned cvtpk(float lo, float hi) { f32x2_t v = {lo, hi}; bf16x2_t b = __builtin_convertvector(v, bf16x2_t); return __builtin_bit_cast(unsigned, b); }
DI s16x4 vtr(const LAS unsigned char* p) { return __builtin_bit_cast(s16x4, __builtin_amdgcn_ds_read_tr16_b64_v4i16((LAS s16x4*)p)); }
DI float xhalf_max(float m) { auto rr = __builtin_amdgcn_permlane32_swap(__float_as_uint(m), __float_as_uint(m), false, false); return fmaxf(__uint_as_float(rr[0]), __uint_as_float(rr[1])); }
DI float xhalf_sum(float m) { auto rr = __builtin_amdgcn_permlane32_swap(__float_as_uint(m), __float_as_uint(m), false, false); return __uint_as_float(rr[0]) + __uint_as_float(rr[1]); }
DI size_t keyrow(int b, int t, int key) { return t < 4 ? (size_t)NLAT + b * 256 + t * 64 + key : (size_t)b * SEQ + (t - 4) * 64 + key; }

#define ATT_BAR_REAL() asm volatile("s_waitcnt lgkmcnt(0)\n\ts_barrier" ::: "memory")
#define ATT_BAR() do { if (MODE == 0) ATT_BAR_REAL(); } while (0)
template <int MODE> DI void attn_phase(unsigned char* lds_generic, const bf16_t* Q, const bf16_t* KV, const bf16_t* KR, const bf16_t* Z1, bf16_t* MIX1) {
    LAS unsigned char* L = (LAS unsigned char*)lds_generic;
    int tid_ = threadIdx.x; asm volatile("" : "+v"(tid_));
    const int tid = tid_, lane = tid & 63, r32 = lane & 31, hi = lane >> 5, wid = __builtin_amdgcn_readfirstlane(tid >> 6);
    const bool grpB = wid >= 4;
    const int G = gridDim.x, vcu = (G % 8 == 0) ? ((int)blockIdx.x % 8) * (G / 8) + (int)blockIdx.x / 8 : (int)blockIdx.x;
    LAS float* wsf = (LAS float*)(L + OFF_WS + wid * 256);
    LAS unsigned char* ost = L + OFF_OST + wid * 4096;
    const int skey = tid >> 3, sch = tid & 7, skey2 = (tid & 255) >> 2, sch2 = tid & 3;
    const int l16 = lane & 15, q4 = l16 >> 2, p4 = l16 & 3, cgrp = (lane >> 4) & 1;
    const int voff = (4 * hi + q4) * VSTR + (16 * cgrp + 4 * p4) * 2;
    const int koff = r32 * KSTR + hi * 16;
    for (int u = vcu; u < 2048; u += G) {
        const int qb = u & 7, h = (u >> 3) & 7, b = u >> 6;
        const int row0 = b * SEQ + qb * 256 + wid * 32;
        bf16x8 qr[6];
#pragma unroll
        for (int d0 = 0; d0 < 6; ++d0) qr[d0] = *(const bf16x8*)(Q + (size_t)(row0 + r32) * 768 + h * 96 + d0 * 16 + hi * 8);
        f32x16 o0, o1, negm, p0, p1;
#pragma unroll
        for (int r = 0; r < 16; ++r) { o0[r] = 0.f; o1[r] = 0.f; negm[r] = 0.f; p0[r] = 0.f; p1[r] = 0.f; }
        float m = 0.f, lsum = 0.f;
        v4u skn, sv, skr;
#define STAGE_LOAD(tt) do { const size_t kr0_ = keyrow(b, (tt), skey), kr2_ = keyrow(b, (tt), skey2); \
            skn = *(const v4u*)(KV + kr0_ * 1024 + h * 128 + sch * 8); sv = *(const v4u*)(KV + kr0_ * 1024 + h * 128 + 64 + sch * 8); \
            skr = *(const v4u*)(KR + kr2_ * 32 + sch2 * 8); } while (0)
#define STAGE_WRITE(bo) do { *(LAS v4u*)(L + (bo) + skey * KSTR + sch * 16) = skn; *(LAS v4u*)(L + (bo) + KBUF + skey * VSTR + sch * 16) = sv; \
            if (tid < 256) *(LAS v4u*)(L + (bo) + skey2 * KSTR + 128 + sch2 * 16) = skr; } while (0)
#define QK_STEP(bo, first) do { \
            const LAS unsigned char* kb_ = L + (bo) + koff; \
            bf16x8 kf_[12]; \
            _Pragma("unroll") for (int d0 = 0; d0 < 6; ++d0) { kf_[2 * d0] = *(const LAS bf16x8*)(kb_ + d0 * 32); kf_[2 * d0 + 1] = *(const LAS bf16x8*)(kb_ + 32 * KSTR + d0 * 32); } \
            p0 = __builtin_amdgcn_mfma_f32_32x32x16_bf16(kf_[0], qr[0], negm, 0, 0, 0); p1 = __builtin_amdgcn_mfma_f32_32x32x16_bf16(kf_[1], qr[0], negm, 0, 0, 0); \
            _Pragma("unroll") for (int d0 = 1; d0 < 6; ++d0) { \
                p0 = __builtin_amdgcn_mfma_f32_32x32x16_bf16(kf_[2 * d0], qr[d0], p0, 0, 0, 0); p1 = __builtin_amdgcn_mfma_f32_32x32x16_bf16(kf_[2 * d0 + 1], qr[d0], p1, 0, 0, 0); } \
            if (MODE == 2) break; \
            float ra_ = fmaxf(fmaxf(p0[0], p0[1]), p1[0]), rb_ = fmaxf(fmaxf(p0[2], p0[3]), p1[1]); ra_ = fmaxf(fmaxf(ra_, p1[2]), p1[3]); \
            _Pragma("unroll") for (int r = 4; r < 16; r += 4) { ra_ = fmaxf(fmaxf(ra_, p0[r]), p0[r + 1]); rb_ = fmaxf(fmaxf(rb_, p0[r + 2]), p0[r + 3]); ra_ = fmaxf(fmaxf(ra_, p1[r]), p1[r + 1]); rb_ = fmaxf(fmaxf(rb_, p1[r + 2]), p1[r + 3]); } \
            const float rel_ = xhalf_max(fmaxf(ra_, rb_)); \
            if (first) { m = rel_; \
                _Pragma("unroll") for (int r = 0; r < 16; ++r) { p0[r] -= rel_; p1[r] -= rel_; negm[r] = -m; } \
            } else if (__any(rel_ > THR)) { const float d_ = fmaxf(rel_, 0.f), al_ = __builtin_amdgcn_exp2f(-d_); \
                m += d_; lsum *= al_; \
                _Pragma("unroll") for (int r = 0; r < 16; ++r) { p0[r] -= d_; p1[r] -= d_; negm[r] = -m; } \
                if (hi == 0) wsf[r32] = al_; \
                _Pragma("unroll") for (int r = 0; r < 16; ++r) { const float f_ = wsf[crow(r, hi)]; o0[r] *= f_; o1[r] *= f_; } } \
        } while (0)
#define SMPV_STEP(bo) do { \
            const LAS unsigned char* vb_ = L + (bo) + KBUF + voff; \
            s16x4 vl_[8], vh_[8]; \
            _Pragma("unroll") for (int ks = 0; ks < 4; ++ks) { const LAS unsigned char* vk_ = vb_ + ks * 16 * VSTR; \
                vl_[2 * ks] = vtr(vk_); vh_[2 * ks] = vtr(vk_ + 8 * VSTR); vl_[2 * ks + 1] = vtr(vk_ + 64); vh_[2 * ks + 1] = vtr(vk_ + 8 * VSTR + 64); } \
            float ps_ = 0.f; \
            if (MODE != 2) { _Pragma("unroll") for (int r = 0; r < 16; ++r) { p0[r] = __builtin_amdgcn_exp2f(p0[r]); p1[r] = __builtin_amdgcn_exp2f(p1[r]); ps_ += p0[r] + p1[r]; } } else ps_ = p0[0]; \
            lsum += ps_; \
            _Pragma("unroll") for (int ks = 0; ks < 4; ++ks) { \
                v4u pw_; \
                if (ks < 2) { pw_.x = cvtpk(p0[8 * ks + 0], p0[8 * ks + 1]); pw_.y = cvtpk(p0[8 * ks + 2], p0[8 * ks + 3]); pw_.z = cvtpk(p0[8 * ks + 4], p0[8 * ks + 5]); pw_.w = cvtpk(p0[8 * ks + 6], p0[8 * ks + 7]); } \
                else { pw_.x = cvtpk(p1[8 * ks - 16], p1[8 * ks - 15]); pw_.y = cvtpk(p1[8 * ks - 14], p1[8 * ks - 13]); pw_.z = cvtpk(p1[8 * ks - 12], p1[8 * ks - 11]); pw_.w = cvtpk(p1[8 * ks - 10], p1[8 * ks - 9]); } \
                const bf16x8 pa_ = __builtin_bit_cast(bf16x8, pw_); \
                const bf16x8 v0_ = {vl_[2 * ks][0], vl_[2 * ks][1], vl_[2 * ks][2], vl_[2 * ks][3], vh_[2 * ks][0], vh_[2 * ks][1], vh_[2 * ks][2], vh_[2 * ks][3]}; \
                const bf16x8 v1_ = {vl_[2 * ks + 1][0], vl_[2 * ks + 1][1], vl_[2 * ks + 1][2], vl_[2 * ks + 1][3], vh_[2 * ks + 1][0], vh_[2 * ks + 1][1], vh_[2 * ks + 1][2], vh_[2 * ks + 1][3]}; \
                o0 = __builtin_amdgcn_mfma_f32_32x32x16_bf16(pa_, v0_, o0, 0, 0, 0); \
                o1 = __builtin_amdgcn_mfma_f32_32x32x16_bf16(pa_, v1_, o1, 0, 0, 0); } \
        } while (0)
        STAGE_LOAD(0); STAGE_WRITE(0); STAGE_WRITE(BUF);
        ATT_BAR_REAL();
        if (!grpB) {
            for (int t = 0; t < 36; ++t) {
                const int cur = (t & 1) * BUF, nxt = BUF - cur;
                if (MODE == 0 && t + 1 < 36) STAGE_LOAD(t + 1);
                QK_STEP(cur, t == 0);
                ATT_BAR();
                SMPV_STEP(cur);
                if (MODE == 0 && t + 1 < 36) STAGE_WRITE(nxt);
                ATT_BAR();
            }
        } else {
            for (int t = 0; t < 36; ++t) {
                const int cur = (t & 1) * BUF, nxt = BUF - cur;
                if (MODE == 0 && t + 1 < 36) STAGE_LOAD(t + 1);
                if (t > 0) SMPV_STEP(nxt);
                ATT_BAR();
                QK_STEP(cur, t == 0);
                if (MODE == 0 && t + 1 < 36) STAGE_WRITE(nxt);
                ATT_BAR();
            }
            SMPV_STEP(BUF);
        }
#undef STAGE_LOAD
#undef STAGE_WRITE
#undef QK_STEP
#undef SMPV_STEP
        lsum = xhalf_sum(lsum);
        if (hi == 0) wsf[32 + r32] = lsum;
#pragma unroll
        for (int r = 0; r < 16; ++r) { const float il = __builtin_amdgcn_rcpf(wsf[32 + crow(r, hi)]); const int q = crow(r, hi);
            *(LAS bf16_t*)(ost + q * 128 + r32 * 2) = f2bf(o0[r] * il); *(LAS bf16_t*)(ost + q * 128 + 64 + r32 * 2) = f2bf(o1[r] * il); }
        v4u gvv[4];
#pragma unroll
        for (int i = 0; i < 4; ++i) gvv[i] = *(const v4u*)(Z1 + (size_t)(row0 + i * 8 + (lane >> 3)) * Z1LD + 1440 + h * 64 + (lane & 7) * 8);
#pragma unroll
        for (int i = 0; i < 4; ++i) {
            const int row = i * 8 + (lane >> 3), ch = lane & 7;
            const v4u ov = *(const LAS v4u*)(ost + row * 128 + ch * 16);
            const v4u gv = gvv[i];
            v4u w;
#pragma unroll
            for (int j = 0; j < 4; ++j) { const float a0 = __uint_as_float(ov[j] << 16), a1 = __uint_as_float(ov[j] & 0xffff0000u), g0 = __uint_as_float(gv[j] << 16), g1 = __uint_as_float(gv[j] & 0xffff0000u);
                w[j] = cvtpk(a0 * pg8::silu_fast(g0), a1 * pg8::silu_fast(g1)); }
            *(v4u*)(MIX1 + (size_t)(row0 + row) * DM + 512 + h * 64 + ch * 8) = w;
        }
        if (MODE != 0) ATT_BAR_REAL();
    }
}
}

#define XB_TMO      128
#define XB_XCNT(j)  (256  + 64 * (j))
#define XB_XSUB(j)  (1280 + 64 * (j))
#define XB_XGEN(j)  (2304 + 64 * (j))
#define XB_TOP      3328
#define XB_TOPGEN   3392
#define XCD_BAR_WORDS 3456
#define XB_SPIN_CAP (1u << 18)

__device__ __forceinline__ unsigned xb_ld(unsigned* p)              { return __hip_atomic_load(p, __ATOMIC_RELAXED, __HIP_MEMORY_SCOPE_AGENT); }
__device__ __forceinline__ unsigned xb_add(unsigned* p, unsigned v) { return __hip_atomic_fetch_add(p, v, __ATOMIC_RELAXED, __HIP_MEMORY_SCOPE_AGENT); }
__device__ __forceinline__ unsigned xb_xcc_id() { return (unsigned)__builtin_amdgcn_s_getreg((3 << 11) | 20) & 0xFu; }
#define XB_SPIN(cond, bar) do { unsigned _sp = 0; while (cond) { __builtin_amdgcn_s_sleep(1); \
    if ((++_sp & 255u) == 0u) { if (xb_ld(&(bar)[XB_TMO])) break; if (_sp > XB_SPIN_CAP) { atomicAdd(&(bar)[XB_TMO], 1u); break; } } } } while (0)

namespace mixp {
typedef short bf16x8 __attribute__((ext_vector_type(8)));
typedef short s16x4 __attribute__((ext_vector_type(4)));
typedef float f32x16 __attribute__((ext_vector_type(16)));
constexpr int WSTR = 272, XSTR = 320, ASTR = 272;
constexpr int OFF_WT = 0, OFF_X = 128 * WSTR, OFF_AH = OFF_X + 128 * XSTR, LDS_TOTAL = OFF_AH + 144 * ASTR;
DI void unpack8(const v4u& v, float (&f)[8]) {
#pragma unroll
    for (int i = 0; i < 4; ++i) { f[2 * i] = __uint_as_float(v[i] << 16); f[2 * i + 1] = __uint_as_float(v[i] & 0xffff0000u); } }
DI v4u pack8(const float (&f)[8]) { return (v4u){att::cvtpk(f[0], f[1]), att::cvtpk(f[2], f[3]), att::cvtpk(f[4], f[5]), att::cvtpk(f[6], f[7])}; }

template <bool POOL>
DI void mixer_items(LAS unsigned char* L, const int gh, const bf16_t* Z0, const float* pscale, const float* sgu_b, bf16_t* MIX0, unsigned* flag, const unsigned need, unsigned* bar) {
    int tid_ = threadIdx.x; asm volatile("" : "+v"(tid_));
    const int tid = tid_, lane = tid & 63, r32 = lane & 31, hi = lane >> 5, wid = __builtin_amdgcn_readfirstlane(tid >> 6), wr = wid >> 1, wc = wid & 1;
    const int G = gridDim.x, c = blockIdx.x;
    const bool xl = (G == 256); const int kq = c >> 6, xq = c & 7;
#define MIX_CHUNK(it_) (xl ? ((((((kq + 4 * (it_)) >> 3) << 3) + xq) << 3) + ((kq + 4 * (it_)) & 7)) : ((c >> 3) + (it_) * (G >> 3)))
    const int l16 = lane & 15, q4 = l16 >> 2, p4 = l16 & 3, cgrp = (lane >> 4) & 1;
    constexpr int NPRE = POOL ? 5 : 4;
    v4u pre[NPRE], gA[4];
    const int nchunk = NROW / 128, nit = xl ? 18 : (nchunk - (c >> 3) + (G >> 3) - 1) / (G >> 3);
#define MIX_PREFETCH(chunk_) do { const int rb_ = (chunk_) * 128; \
        if (POOL) { const RowInfo ri_ = rowinfo(rb_); \
            _Pragma("unroll") for (int i = 0; i < 5; ++i) { const int e = tid + NT * i, rr = e >> 4, ch = e & 15, t = ri_.t - 8 + rr; \
                if (e < 144 * 16 && t >= 0 && t < ri_.L) pre[i] = *(const v4u*)(Z0 + (size_t)(ri_.base + t) * Z0LD + gh * 128 + ch * 8); } \
        } else { const bf16_t* vp_ = Z0 + (size_t)(rb_ + (tid >> 2)) * Z0LD + 1536 + gh * 128 + (tid & 3) * 32; \
            _Pragma("unroll") for (int k = 0; k < 4; ++k) pre[k] = *(const v4u*)(vp_ + k * 8); } } while (0)
    bool waited = false;
    if (nit > 0) MIX_PREFETCH(MIX_CHUNK(0));
    for (int it = 0; it < nit; ++it) {
        const int chunk = MIX_CHUNK(it), nextc = MIX_CHUNK(it + 1);
        const int row_base = chunk * 128;
        const RowInfo ri = rowinfo(row_base);
        __syncthreads();
        if (POOL) {
#pragma unroll
            for (int i = 0; i < 5; ++i) { const int e = tid + NT * i, rr = e >> 4, ch = e & 15, t = ri.t - 8 + rr;
                if (e < 144 * 16 && t >= 0 && t < ri.L) *(LAS v4u*)(L + OFF_AH + rr * ASTR + ch * 16) = pre[i]; }
        } else {
            const int tl = tid >> 2, cq = tid & 3;
            float f[4][8]; float sm = 0.f;
#pragma unroll
            for (int k = 0; k < 4; ++k) { unpack8(pre[k], f[k]);
#pragma unroll
                for (int i = 0; i < 8; ++i) sm += f[k][i]; }
            sm += __shfl_xor(sm, 1); sm += __shfl_xor(sm, 2);
            const float mu = sm * (1.f / 128.f); float qs = 0.f;
#pragma unroll
            for (int k = 0; k < 4; ++k)
#pragma unroll
                for (int i = 0; i < 8; ++i) { f[k][i] -= mu; qs += f[k][i] * f[k][i]; }
            qs += __shfl_xor(qs, 1); qs += __shfl_xor(qs, 2);
            const float rs = rsqrtf(qs * (1.f / 128.f) + EPS);
#pragma unroll
            for (int k = 0; k < 4; ++k) {
#pragma unroll
                for (int i = 0; i < 8; ++i) f[k][i] *= rs;
                *(LAS v4u*)(L + OFF_X + tl * XSTR + (cq * 4 + k) * 16) = pack8(f[k]); }
        }
#pragma unroll
        for (int it = 0; it < 4; ++it) { const size_t grow = (size_t)row_base + 32 * wr + it * 8 + (lane >> 3); const int col = 64 * wc + (lane & 7) * 8;
            gA[it] = *(const v4u*)(Z0 + grow * Z0LD + (POOL ? 512 : 1024) + gh * 128 + col); }
        if (flag && !waited && it + 1 < nit && nextc >= NLAT / 128) {
            if (threadIdx.x == 0) { XB_SPIN(xb_ld(flag) < need, bar); __builtin_amdgcn_fence(__ATOMIC_ACQUIRE, "agent"); asm volatile("s_waitcnt vmcnt(0)" ::: "memory"); }
            __syncthreads(); waited = true; }
        if (it + 1 < nit) MIX_PREFETCH(nextc);
        __syncthreads();
        if (POOL) {
            const int w = 2 << gh, ch = tid & 15, ts = (tid >> 4) * 4, t0 = ri.t;
            float acc[8];
#pragma unroll
            for (int i = 0; i < 8; ++i) acc[i] = 0.f;
            int lo = t0 + ts - (w >> 1); if (lo < 0) lo = 0; int hh = t0 + ts + (w >> 1); if (hh > ri.L) hh = ri.L;
            for (int tt = lo; tt < hh; ++tt) { float f[8]; { const v4u tv = *(const LAS v4u*)(L + OFF_AH + (tt - t0 + 8) * ASTR + ch * 16); unpack8(tv, f); }
#pragma unroll
                for (int i = 0; i < 8; ++i) acc[i] += f[i]; }
#pragma unroll
            for (int k = 0; k < 4; ++k) {
                const int t = t0 + ts + k;
                if (k) { int nlo = t - (w >> 1); if (nlo < 0) nlo = 0; int nhh = t + (w >> 1); if (nhh > ri.L) nhh = ri.L;
                    if (nhh > hh) { float f[8]; { const v4u tv = *(const LAS v4u*)(L + OFF_AH + (hh - t0 + 8) * ASTR + ch * 16); unpack8(tv, f); }
#pragma unroll
                        for (int i = 0; i < 8; ++i) acc[i] += f[i]; }
                    if (nlo > lo) { float f[8]; { const v4u tv = *(const LAS v4u*)(L + OFF_AH + (lo - t0 + 8) * ASTR + ch * 16); unpack8(tv, f); }
#pragma unroll
                        for (int i = 0; i < 8; ++i) acc[i] -= f[i]; }
                    lo = nlo; hh = nhh; }
                const float inv = 1.f / (float)(hh - lo);
                float a[8], d[8]; { const v4u tv = *(const LAS v4u*)(L + OFF_AH + (ts + k + 8) * ASTR + ch * 16); unpack8(tv, a); }
#pragma unroll
                for (int i = 0; i < 8; ++i) d[i] = acc[i] * inv - a[i];
                *(LAS v4u*)(L + OFF_X + (ts + k) * WSTR + ch * 16) = pack8(d);
            }
            __syncthreads();
        }
        f32x16 acc0, acc1;
#pragma unroll
        for (int r = 0; r < 16; ++r) { acc0[r] = 0.f; acc1[r] = 0.f; }
        if (POOL) {
            const LAS unsigned char* ap = L + OFF_X + (32 * wr + r32) * WSTR + hi * 16;
            const LAS unsigned char* bp = L + OFF_WT + (64 * wc + r32) * WSTR + hi * 16;
#pragma unroll
            for (int ks = 0; ks < 8; ++ks) {
                const bf16x8 a = *(const LAS bf16x8*)(ap + ks * 32), b0 = *(const LAS bf16x8*)(bp + ks * 32), b1 = *(const LAS bf16x8*)(bp + 32 * WSTR + ks * 32);
                acc0 = __builtin_amdgcn_mfma_f32_32x32x16_bf16(a, b0, acc0, 0, 0, 0); acc1 = __builtin_amdgcn_mfma_f32_32x32x16_bf16(a, b1, acc1, 0, 0, 0); }
        } else {
            const LAS unsigned char* ap = L + OFF_WT + (32 * wr + r32) * WSTR + hi * 16;
            const LAS unsigned char* vb = L + OFF_X + (8 * hi + q4) * XSTR + (64 * wc + 16 * cgrp + 4 * p4) * 2;
#pragma unroll
            for (int ks = 0; ks < 8; ++ks) {
                const bf16x8 a = *(const LAS bf16x8*)(ap + ks * 32);
                const LAS unsigned char* vk = vb + ks * 16 * XSTR;
                const s16x4 l0 = att::vtr(vk), h0 = att::vtr(vk + 4 * XSTR), l1 = att::vtr(vk + 64), h1 = att::vtr(vk + 4 * XSTR + 64);
                const bf16x8 b0 = {l0[0], l0[1], l0[2], l0[3], h0[0], h0[1], h0[2], h0[3]}, b1 = {l1[0], l1[1], l1[2], l1[3], h1[0], h1[1], h1[2], h1[3]};
                acc0 = __builtin_amdgcn_mfma_f32_32x32x16_bf16(a, b0, acc0, 0, 0, 0); acc1 = __builtin_amdgcn_mfma_f32_32x32x16_bf16(a, b1, acc1, 0, 0, 0); }
        }
        __syncthreads();
        LAS unsigned char* ost = L + OFF_X + wid * 4096;
#pragma unroll
        for (int r = 0; r < 16; ++r) { const int q = att::crow(r, hi);
            *(LAS bf16_t*)(ost + q * 128 + r32 * 2) = f2bf(acc0[r]); *(LAS bf16_t*)(ost + q * 128 + 64 + r32 * 2) = f2bf(acc1[r]); }
        f32x4g ps0 = {0.f, 0.f, 0.f, 0.f}, ps1 = ps0; float biasv[4] = {0.f, 0.f, 0.f, 0.f};
        if (POOL) { ps0 = *(const f32x4g*)(pscale + gh * 128 + 64 * wc + (lane & 7) * 8); ps1 = *(const f32x4g*)(pscale + gh * 128 + 64 * wc + (lane & 7) * 8 + 4); }
        else {
#pragma unroll
            for (int it = 0; it < 4; ++it) biasv[it] = sgu_b[gh * 128 + 32 * wr + it * 8 + (lane >> 3)]; }
#pragma unroll
        for (int it = 0; it < 4; ++it) {
            const int row = it * 8 + (lane >> 3), ch = lane & 7, col = 64 * wc + ch * 8;
            const size_t grow = (size_t)row_base + 32 * wr + row;
            float y[8]; { const v4u tv = *(const LAS v4u*)(ost + row * 128 + ch * 16); unpack8(tv, y); }
            float o[8];
            if (POOL) {
                float ga[8]; unpack8(gA[it], ga);
#pragma unroll
                for (int i = 0; i < 8; ++i) o[i] = y[i] * (i < 4 ? ps0[i & 3] : ps1[i & 3]) * ga[i];
                *(v4u*)(MIX0 + grow * DM + gh * 128 + col) = pack8(o);
            } else {
                float ug[8]; unpack8(gA[it], ug);
                const float bias = biasv[it];
#pragma unroll
                for (int i = 0; i < 8; ++i) o[i] = (y[i] + bias) * ug[i];
                *(v4u*)(MIX0 + grow * DM + 512 + gh * 128 + col) = pack8(o);
            }
        }
    }
#undef MIX_PREFETCH
#undef MIX_CHUNK
}
DI void mixer_phase(unsigned char* lds_generic, const bf16_t* Z0, const bf16_t* WPOOL, const bf16_t* WSGU, const float* pscale, const float* sgu_b, bf16_t* MIX0, unsigned* flag, const unsigned need, unsigned* bar) {
    LAS unsigned char* L = (LAS unsigned char*)lds_generic;
    const int tid = threadIdx.x, j = (gridDim.x == 256) ? (((int)blockIdx.x >> 3) & 7) : ((int)blockIdx.x & 7), gh = j & 3;
    {   const bf16_t* W = (j < 4 ? WPOOL : WSGU) + gh * 16384;
        __syncthreads();
#pragma unroll
        for (int i = 0; i < 4; ++i) { const int e = tid + NT * i, row = e >> 4, ch = e & 15; *(LAS v4u*)(L + OFF_WT + row * WSTR + ch * 16) = *(const v4u*)(W + row * 128 + ch * 8); }
    }
    if (j < 4) mixer_items<true>(L, gh, Z0, pscale, sgu_b, MIX0, flag, need, bar); else mixer_items<false>(L, gh, Z0, pscale, sgu_b, MIX0, flag, need, bar);
}
}
struct XcdBarrier {
    unsigned* bar; unsigned x;
    volatile LAS unsigned* st;
};

__device__ __forceinline__ XcdBarrier xcd_barrier_post(unsigned* bar, volatile LAS unsigned* st) {
    XcdBarrier b; b.bar = bar; b.x = xb_xcc_id(); b.st = st;
    if (threadIdx.x == 0) (void)xb_add(&bar[XB_XCNT(b.x)], 1u);
    return b;
}
__device__ __forceinline__ void xcd_barrier_complete(unsigned* bar, unsigned x, unsigned& nloc, unsigned& nx) {
    const unsigned G = gridDim.x * gridDim.y * gridDim.z;
    unsigned sum, cnt, mine, sp = 0u;
    for (;;) {
        sum = 0u; cnt = 0u; mine = 0u;
#pragma unroll
        for (unsigned j = 0; j < 16; ++j) { const unsigned c = xb_ld(&bar[XB_XCNT(j)]); sum += c; cnt += (c > 0u) ? 1u : 0u; mine = (j == x) ? c : mine; }
        if (sum == G) break;
        __builtin_amdgcn_s_sleep(1);
        if ((++sp & 255u) == 0u) { if (xb_ld(&bar[XB_TMO])) break; if (sp > XB_SPIN_CAP) { atomicAdd(&bar[XB_TMO], 1u); break; } }
    }
    nloc = mine > 0u ? mine : 1u; nx = cnt > 0u ? cnt : 1u;
}

__device__ __forceinline__ void xcd_barrier(const XcdBarrier& b) {
    asm volatile("s_waitcnt vmcnt(0)" ::: "memory");
    __syncthreads();
    if (threadIdx.x == 0) {
        unsigned* bar = b.bar;
        __builtin_amdgcn_s_waitcnt(0);
        unsigned nloc = b.st[0], nx = b.st[1];
        if (nloc == 0u) { xcd_barrier_complete(bar, b.x, nloc, nx); b.st[0] = nloc; b.st[1] = nx; }
        const unsigned old = xb_add(&bar[XB_XSUB(b.x)], 1u);
        const unsigned gen = old / nloc;
        if (old + 1u == (gen + 1u) * nloc) {
            __builtin_amdgcn_fence(__ATOMIC_RELEASE, "agent");
            asm volatile("s_waitcnt vmcnt(0)" ::: "memory");
            const unsigned og = xb_add(&bar[XB_TOP], 1u);
            const unsigned tg = og / nx;
            if (og + 1u == (tg + 1u) * nx) xb_add(&bar[XB_TOPGEN], 1u);
            else XB_SPIN(xb_ld(&bar[XB_TOPGEN]) == tg, bar);
            __builtin_amdgcn_fence(__ATOMIC_ACQUIRE, "agent");
            xb_add(&bar[XB_XGEN(b.x)], 1u);
            asm volatile("s_waitcnt vmcnt(0)" ::: "memory");
        } else {
            XB_SPIN(xb_ld(&bar[XB_XGEN(b.x)]) == gen, bar);
            __builtin_amdgcn_fence(__ATOMIC_ACQUIRE, "agent");
            asm volatile("s_waitcnt vmcnt(0)" ::: "memory");
        }
    }
    __syncthreads();
}


typedef unsigned u32x2g __attribute__((ext_vector_type(2)));
DI void h0_rows(int r0, int n, int w0, int nw, const float* x, const float* ctx, const float* MOD0, bf16_t* H0) {
    int lane = threadIdx.x & 63; asm volatile("" : "+v"(lane), "+v"(w0));
    const float* mod = MOD0 + (r0 < NLAT ? (r0 >> 11) : 32) * 3072;
    f32x4g sc[4], sh[4];
#pragma unroll
    for (int j = 0; j < 4; ++j) { sc[j] = *(const f32x4g*)(mod + 1024 + 4 * lane + 256 * j) + 1.f; sh[j] = *(const f32x4g*)(mod + 4 * lane + 256 * j); }
    for (int rb = r0 + w0; rb < r0 + n; rb += 4 * nw) {
        f32x4g xv[4][4];
#pragma unroll
        for (int q = 0; q < 4; ++q) { int row = rb + q * nw; if (row >= r0 + n) row = rb;
            const float* src = row < NLAT ? x + (size_t)row * DM : ctx + (size_t)(row - NLAT) * DM;
#pragma unroll
            for (int j = 0; j < 4; ++j) xv[q][j] = *(const f32x4g*)(src + 4 * lane + 256 * j); }
#pragma unroll
        for (int q = 0; q < 4; ++q) { const int row = rb + q * nw; if (row >= r0 + n) break;
#pragma unroll
            for (int j = 0; j < 4; ++j) { const int col = 4 * lane + 256 * j;
                const f32x4g h = xv[q][j] * sc[j] + sh[j];
                *(u32x2g*)(H0 + (size_t)row * DM + col) = (u32x2g){att::cvtpk(h[0], h[1]), att::cvtpk(h[2], h[3])}; } }
    }
}
typedef _Float16 h16x8g __attribute__((ext_vector_type(8)));
template <bool ADD>
DI void ln_load_stats4(const h16_t* src, size_t ld, int row0, int rstep, int rend, float (&v)[4][16], float (&mu)[4], float (&rs)[4], int lane, const f32x4g (&ad)[4]) {
    h16x8g hv[4][2];
#pragma unroll
    for (int q = 0; q < 4; ++q) { int row = row0 + q * rstep; if (row >= rend) row = row0;
#pragma unroll
        for (int j = 0; j < 2; ++j) hv[q][j] = *(const h16x8g*)(src + (size_t)row * ld + 8 * lane + 512 * j); }
    float s[4], ss[4];
#pragma unroll
    for (int q = 0; q < 4; ++q) { s[q] = 0.f; ss[q] = 0.f;
#pragma unroll
        for (int j = 0; j < 2; ++j)
#pragma unroll
            for (int i = 0; i < 8; ++i) { const float f = (float)hv[q][j][i] + (ADD ? ad[2 * j + (i >> 2)][i & 3] : 0.f); v[q][8 * j + i] = f; s[q] += f; ss[q] += f * f; } }
#pragma unroll
    for (int o = 1; o < 64; o <<= 1)
#pragma unroll
        for (int q = 0; q < 4; ++q) { s[q] += __shfl_xor(s[q], o); ss[q] += __shfl_xor(ss[q], o); }
#pragma unroll
    for (int q = 0; q < 4; ++q) { mu[q] = s[q] * (1.f / DM); const float var = fmaxf(ss[q] * (1.f / DM) - mu[q] * mu[q], 0.f); rs[q] = rsqrtf(var + EPS); }
}
DI void ln0_rows(int r0, int n, const h16_t* R0, size_t ld, const float* g, const float* bta, const float* MOD1, float* ST1, bf16_t* H1) {
    int wv = threadIdx.x >> 6, lane = threadIdx.x & 63; asm volatile("" : "+v"(wv), "+v"(lane));
    const float* mod = MOD1 + (r0 < NLAT ? (r0 >> 11) : 32) * 3072;
    f32x4g gg[4], bb[4], sc[4], sh[4];
#pragma unroll
    for (int j = 0; j < 2; ++j)
#pragma unroll
        for (int i4 = 0; i4 < 2; ++i4) { const int col = 8 * lane + 512 * j + 4 * i4;
            gg[2 * j + i4] = *(const f32x4g*)(g + col); bb[2 * j + i4] = *(const f32x4g*)(bta + col); sc[2 * j + i4] = *(const f32x4g*)(mod + 1024 + col) + 1.f; sh[2 * j + i4] = *(const f32x4g*)(mod + col); }
    for (int rb = r0 + wv; rb < r0 + n; rb += 32) {
        float v[4][16], mu[4], rs[4];
        ln_load_stats4<false>(R0, ld, rb, 8, r0 + n, v, mu, rs, lane, gg);
#pragma unroll
        for (int q = 0; q < 4; ++q) { const int row = rb + 8 * q; if (row >= r0 + n) break;
            if (lane == 0 && row < NLAT) { ST1[2 * (size_t)row] = mu[q]; ST1[2 * (size_t)row + 1] = rs[q]; }
#pragma unroll
            for (int j = 0; j < 2; ++j) { const int col = 8 * lane + 512 * j; float x1[8], hh[8];
#pragma unroll
                for (int i4 = 0; i4 < 2; ++i4)
#pragma unroll
                    for (int i = 0; i < 4; ++i) { x1[4 * i4 + i] = (v[q][8 * j + 4 * i4 + i] - mu[q]) * rs[q] * gg[2 * j + i4][i] + bb[2 * j + i4][i]; hh[4 * i4 + i] = x1[4 * i4 + i] * sc[2 * j + i4][i] + sh[2 * j + i4][i]; }
                *(v4u*)(H1 + (size_t)row * DM + col) = (v4u){att::cvtpk(hh[0], hh[1]), att::cvtpk(hh[2], hh[3]), att::cvtpk(hh[4], hh[5]), att::cvtpk(hh[6], hh[7])}; } }
    }
}
DI void ln1_rows(int r0, int n, const h16_t* T, const float* b0, const float* g, const float* bta, float* out) {
    int wv = threadIdx.x >> 6, lane = threadIdx.x & 63; asm volatile("" : "+v"(wv), "+v"(lane));
    f32x4g gg[4], bb[4], ba[4];
#pragma unroll
    for (int j = 0; j < 2; ++j)
#pragma unroll
        for (int i4 = 0; i4 < 2; ++i4) { const int col = 8 * lane + 512 * j + 4 * i4; gg[2 * j + i4] = *(const f32x4g*)(g + col); bb[2 * j + i4] = *(const f32x4g*)(bta + col); ba[2 * j + i4] = *(const f32x4g*)(b0 + col) * ALPHA; }
    for (int rb = r0 + wv; rb < r0 + n; rb += 32) {
        float v[4][16], mu[4], rs[4];
        ln_load_stats4<true>(T, DM, rb, 8, r0 + n, v, mu, rs, lane, ba);
#pragma unroll
        for (int q = 0; q < 4; ++q) { const int row = rb + 8 * q; if (row >= r0 + n) break;
#pragma unroll
            for (int j = 0; j < 2; ++j) { const int col = 8 * lane + 512 * j;
#pragma unroll
                for (int i4 = 0; i4 < 2; ++i4) { f32x4g o;
#pragma unroll
                    for (int i = 0; i < 4; ++i) o[i] = (v[q][8 * j + 4 * i4 + i] - mu[q]) * rs[q] * gg[2 * j + i4][i] + bb[2 * j + i4][i];
                    *(f32x4g*)(out + (size_t)row * DM + col + 4 * i4) = o; } } }
    }
}
DI void split_bf16x8(const float (&v)[8], pg8::bf16x8& hi, pg8::bf16x8& lo) {
    pg8::u32x4 h, l;
#pragma unroll
    for (int i = 0; i < 4; ++i) { h[i] = pg8::cvt_pk_bf16(v[2 * i], v[2 * i + 1]);
        l[i] = pg8::cvt_pk_bf16(v[2 * i] - __uint_as_float(h[i] << 16), v[2 * i + 1] - __uint_as_float(h[i] & 0xffff0000u)); }
    hi = __builtin_bit_cast(pg8::bf16x8, h); lo = __builtin_bit_cast(pg8::bf16x8, l);
}
DI void ph_mod(unsigned char* lds_generic, const float* c, const float* c_ctx, const float* w0, const float* b0, const float* w1, const float* b1, float* MOD0, float* MOD1) {
    LAS float* red = (LAS float*)lds_generic;
    int tid_ = threadIdx.x; asm volatile("" : "+v"(tid_));
    const int tid = tid_, wv = tid >> 6, l = tid & 63, l15 = l & 15, lq = l >> 4;
    for (int item = blockIdx.x; item < 192; item += gridDim.x) {
        const int layer = item / 96, n0 = (item % 96) * 32;
        const float* w = layer ? w1 : w0; const float* bb = layer ? b1 : b0; float* outp = layer ? MOD1 : MOD0;
        pg8::f32x4 acc[2][3];
#pragma unroll
        for (int a = 0; a < 2; ++a)
#pragma unroll
            for (int b = 0; b < 3; ++b) acc[a][b] = (pg8::f32x4){0.f, 0.f, 0.f, 0.f};
        for (int s4 = 0; s4 < 4; ++s4) {
            const int kb = 128 * wv + 32 * s4 + 8 * lq;
            float wf[2][8];
#pragma unroll
            for (int nt = 0; nt < 2; ++nt)
#pragma unroll
                for (int j = 0; j < 8; ++j) wf[nt][j] = w[(size_t)(kb + j) * 3072 + n0 + 16 * nt + l15];
            pg8::bf16x8 chi[3], clo[3];
#pragma unroll
            for (int rt = 0; rt < 3; ++rt) {
                const int r = 16 * rt + l15; float cv[8];
                if (r <= 32) { const float* cp = (r < 32 ? c + (size_t)r * DM : c_ctx) + kb; const f32x4g c0 = *(const f32x4g*)cp, c1 = *(const f32x4g*)(cp + 4);
#pragma unroll
                    for (int j = 0; j < 4; ++j) { cv[j] = silu(c0[j]); cv[4 + j] = silu(c1[j]); } }
                else {
#pragma unroll
                    for (int j = 0; j < 8; ++j) cv[j] = 0.f; }
                split_bf16x8(cv, chi[rt], clo[rt]);
            }
#pragma unroll
            for (int nt = 0; nt < 2; ++nt) { pg8::bf16x8 whi, wlo; split_bf16x8(wf[nt], whi, wlo);
#pragma unroll
                for (int rt = 0; rt < 3; ++rt) {
                    acc[nt][rt] = __builtin_amdgcn_mfma_f32_16x16x32_bf16(whi, chi[rt], acc[nt][rt], 0, 0, 0);
                    acc[nt][rt] = __builtin_amdgcn_mfma_f32_16x16x32_bf16(whi, clo[rt], acc[nt][rt], 0, 0, 0);
                    acc[nt][rt] = __builtin_amdgcn_mfma_f32_16x16x32_bf16(wlo, chi[rt], acc[nt][rt], 0, 0, 0); } }
        }
        __syncthreads();
#pragma unroll
        for (int nt = 0; nt < 2; ++nt)
#pragma unroll
            for (int rt = 0; rt < 3; ++rt) *(LAS pg8::f32x4*)(red + ((wv * 6 + nt * 3 + rt) * 64 + l) * 4) = acc[nt][rt];
        __syncthreads();
        for (int e = tid; e < 6 * 64; e += NT) { const int tile = e >> 6, ll = e & 63, nt = tile / 3, rt = tile - 3 * nt, r = 16 * rt + (ll & 15), n = n0 + 16 * nt + 4 * (ll >> 4);
            pg8::f32x4 sacc = *(const f32x4g*)(bb + n);
#pragma unroll
            for (int q = 0; q < 8; ++q) sacc += *(const LAS pg8::f32x4*)(red + ((q * 6 + tile) * 64 + ll) * 4);
            if (r <= 32) *(f32x4g*)(outp + (size_t)r * 3072 + n) = sacc; }
    }
}
constexpr int LDS_MISC_OFF = 136 * 1024 - 64;
struct Params { const float* in[25]; float* out; char* ws; int never; int pad; };

__global__ void __launch_bounds__(NT, 2) mega(Params p) {
    extern __shared__ __attribute__((aligned(16))) unsigned char lds_raw[];
    float* lds = (float*)lds_raw;
    cg::grid_group grid = cg::this_grid();
    const float* x = p.in[0]; const float* c = p.in[1]; const float* ctx = p.in[2]; const float* c_ctx = p.in[3];
    const float* ab_w_mod = p.in[4]; const float* ab_b_mod = p.in[5]; const float* ab_w_in = p.in[6];
    const float* ab_pool_w = p.in[7]; const float* ab_pool_scale = p.in[8]; const float* ab_sgu_w = p.in[9]; const float* ab_sgu_b = p.in[10];
    const float* ab_w_out = p.in[11]; const float* ab_ln_g = p.in[12]; const float* ab_ln_b = p.in[13];
    const float* cd_w_mod = p.in[14]; const float* cd_b_mod = p.in[15]; const float* cd_w_in = p.in[16];
    const float* cd_fnet_w = p.in[17]; const float* cd_q_norm = p.in[18]; const float* cd_kv_norm = p.in[19];
    const float* cd_w_q_up = p.in[20]; const float* cd_w_kv_up = p.in[21]; const float* cd_w_out = p.in[22];
    const float* cd_ln_g = p.in[23]; const float* cd_ln_b = p.in[24];
    float* out = p.out; char* ws = p.ws;
    bf16_t* H0 = (bf16_t*)(ws + OFF_A); bf16_t* MIX0 = H0; bf16_t* H1 = H0; bf16_t* Q = H0; bf16_t* KR = (bf16_t*)(ws + OFF_KR);
    bf16_t* Z0 = (bf16_t*)(ws + OFF_B); h16_t* R0 = (h16_t*)(ws + OFF_B); bf16_t* Z1 = (bf16_t*)(ws + OFF_B); h16_t* TEMP = (h16_t*)(ws + OFF_B); h16_t* R0C = (h16_t*)(ws + OFF_R0C); h16_t* X1h = (h16_t*)out;
    bf16_t* KV = (bf16_t*)(ws + OFF_KV); float* DT = (float*)(ws + OFF_KV); float* VN = (float*)(ws + OFF_T1);
    bf16_t* GR = (bf16_t*)(ws + OFF_T1); bf16_t* GI = GR + (size_t)NLAT * 512; bf16_t* MIX1 = (bf16_t*)(ws + OFF_MIX1); bf16_t* SPEC = (bf16_t*)(ws + OFF_T1); bf16_t* FT = (bf16_t*)(ws + OFF_FT); bf16_t* DFT = (bf16_t*)(ws + OFF_DFT);
    float* MOD0 = (float*)(ws + OFF_MOD0); float* MOD1 = (float*)(ws + OFF_MOD1);
    float* ST1 = (float*)(ws + OFF_ST1); float* RQ = (float*)(ws + OFF_RQ); float* RKV = (float*)(ws + OFF_RKV); float* ROPE = (float*)(ws + OFF_ROPE);
    bf16_t* WIN0 = (bf16_t*)(ws + OFF_WIN0); bf16_t* WOUT0 = (bf16_t*)(ws + OFF_WOUT0); bf16_t* WIN1 = (bf16_t*)(ws + OFF_WIN1); bf16_t* WOUT1 = (bf16_t*)(ws + OFF_WOUT1);
    bf16_t* WPOOL = (bf16_t*)(ws + OFF_WPOOL); bf16_t* WSGU = (bf16_t*)(ws + OFF_WSGU); bf16_t* WFN = (bf16_t*)(ws + OFF_DFT + 8 * MiB);   bf16_t* WQ = (bf16_t*)(ws + OFF_WQ); bf16_t* WKV = (bf16_t*)(ws + OFF_WKV);
    PG8_LAS unsigned char* ldsg = (PG8_LAS unsigned char*)lds_raw;
    const int G = gridDim.x, bid = blockIdx.x;

    volatile LAS unsigned* MISC = (volatile LAS unsigned*)((LAS unsigned char*)lds_raw + LDS_MISC_OFF);
    if (threadIdx.x < 16) MISC[threadIdx.x] = 0u;
    __syncthreads();
    XcdBarrier xb = xcd_barrier_post((unsigned*)(ws + OFF_CTL), MISC);
#define GRID_BAR() xcd_barrier(xb)

    ph_mod(lds_raw, c, c_ctx, ab_w_mod, ab_b_mod, cd_w_mod, cd_b_mod, MOD0, MOD1);
    auto prep = [&](const int part, const int pb, const int PG) {
        LAS float* ctab = (LAS float*)((LAS unsigned char*)lds_raw + 135168);
        __syncthreads();
        if (part >= 2 && threadIdx.x < 128) { ctab[threadIdx.x] = cospif((float)threadIdx.x * (1.f / 64.f)); ctab[128 + threadIdx.x] = sinpif((float)threadIdx.x * (1.f / 64.f)); }
        __syncthreads();
        const int wave = __builtin_amdgcn_readfirstlane(threadIdx.x >> 6), lane = threadIdx.x & 63;
        LAS float* scr = (LAS float*)((LAS char*)lds_raw + wave * 16384);
        const int gw = pb * 8 + wave, NGW = PG * 8;
        constexpr int I0 = (DM / 64) * (ABIN / 32), I1 = (DM / 64) * (DM / 32), I2 = (DM / 64) * (CDIN / 32), I3 = I1, I4 = 4 * (128 / 64) * (128 / 32), I5 = (256 / 64) * (768 / 32), I6 = (128 / 64) * (1024 / 32);
        if (part == 0) {
            for (int it = gw; it < I0 + I1 + I4; it += NGW) {
                int r = it;
                if (r < I0) { transpose_item(ab_w_in, DM, ABIN, nullptr, WIN0, DM, scr, r, lane, true); continue; } r -= I0;
                if (r < I1) { transpose_item(ab_w_out, DM, DM, nullptr, WOUT0, DM, scr, r, lane); continue; } r -= I1;
                transpose_item(ab_pool_w + (r >> 3) * 16384, 128, 128, nullptr, WPOOL + (r >> 3) * 16384, 128, scr, r & 7, lane);
            }
            for (int i = pb * NT + threadIdx.x; i < 4 * 16384; i += PG * NT) WSGU[i] = f2bf(ab_sgu_w[i]);
            return;
        }
        if (part & 1) {
            for (int it = gw; it < I2; it += NGW) transpose_item(cd_w_in, DM, CDIN, nullptr, WIN1, DM, scr, it, lane);
            for (int i = pb * NT + threadIdx.x; i < 96 * 1024 / 8; i += PG * NT) ((v4u*)(WIN1 + (size_t)CDIN * DM))[i] = (v4u){0u, 0u, 0u, 0u};
            if (part == 1) { __syncthreads(); return; }
        }
        for (int it = gw; it < I3 + I5 + I6; it += NGW) {
            int r = it;
            if (r < I3) { transpose_item(cd_w_out, DM, DM, nullptr, WOUT1, DM, scr, r, lane); continue; } r -= I3;
            if (r < I5) { transpose_item(cd_w_q_up, 256, 768, cd_q_norm, WQ, 256, scr, r, lane); continue; } r -= I5;
            transpose_item(cd_w_kv_up, 128, 1024, cd_kv_norm, WKV, 256, scr, r, lane);
        }
        for (int i = pb * NT + threadIdx.x; i < 1024 * 16; i += PG * NT) ((v4u*)(WKV + (size_t)(i >> 4) * 256 + 128))[i & 15] = (v4u){0u, 0u, 0u, 0u};
        for (int i = pb * NT + threadIdx.x; i < 2048 * 128; i += PG * NT) {
            const int m = i >> 7, l0 = (i & 127) * 8, grp = m >> 9, k = 2 * (m & 511) + (grp & 1); const bool sn = grp >= 2; float v[8];
#pragma unroll
            for (int j = 0; j < 8; ++j) { const int l = l0 + j; const float a = (float)((k * l) & 2047) * (1.f / 1024.f);
                v[j] = !sn ? cospif(a) : (k == 0 ? ((l & 1) ? -1.f : 1.f) : sinpif(a)); }
            ((v4u*)DFT)[i] = (v4u){pk2(v[0], v[1]), pk2(v[2], v[3]), pk2(v[4], v[5]), pk2(v[6], v[7])};
        }
        {   LAS float* colb = scr;
            for (int it = gw; it < 4 * 512; it += NGW) {
                const int h = it >> 9, n = it & 511;
                LDS_WAIT(); asm volatile("" ::: "memory");
                colb[lane] = cd_fnet_w[(size_t)(h * 128 + lane) * 512 + n]; colb[64 + lane] = cd_fnet_w[(size_t)(h * 128 + 64 + lane) * 512 + n];
                LDS_WAIT(); asm volatile("" ::: "memory");
                float a0 = 0.f, a1 = 0.f, a2 = 0.f, a3 = 0.f;
#pragma unroll 8
                for (int cc = 0; cc < 128; ++cc) { const float wv = colb[cc]; const int p0 = (lane * cc) & 127, p1 = ((64 + lane) * cc) & 127;
                    a0 += ctab[p0] * wv; a1 += ctab[p1] * wv; a2 -= ctab[128 + p0] * wv; a3 -= ctab[128 + p1] * wv; }
                bf16_t* wrow = WFN + (size_t)n * 1024 + h * 128;
                wrow[lane] = f2bf(a0 * (1.f / 512.f)); wrow[64 + lane] = f2bf(a1 * (1.f / 512.f)); wrow[512 + lane] = f2bf(a2 * (1.f / 512.f)); wrow[512 + 64 + lane] = f2bf(a3 * (1.f / 512.f));
                bf16_t* wrow2 = wrow + (size_t)512 * 1024;
                wrow2[lane] = f2bf(a0 * (1.f / 512.f)); wrow2[64 + lane] = f2bf(a1 * (1.f / 512.f)); wrow2[512 + lane] = f2bf(-a2 * (1.f / 512.f)); wrow2[512 + 64 + lane] = f2bf(-a3 * (1.f / 512.f));
            }
        }
        __syncthreads();
    };
    prep(0, bid, G);
    if (p.never) grid.sync();
    GRID_BAR();
    h0_rows(NLAT, NCTX, bid * 8 + (threadIdx.x >> 6), G * 8, x, ctx, MOD0, H0);
    for (int pm = bid; pm < 256; pm += G) {
        h0_rows(pm * 256, 256, threadIdx.x >> 6, 8, x, ctx, MOD0, H0);
        __syncthreads();
        pg8::Gemm g{H0, WIN0, NROW, ABIN, DM, DM, DM, 0}; pg8::PanelOrder10 S{pm};
        pg8::EpiZ0 E{Z0};
        pg8::gemm_phase<pg8::EpiZ0, pg8::PanelOrder10, true, true>(ldsg, g, S, E);
    }
    GRID_BAR();
    unsigned* ctxflag = (unsigned*)(ws + OFF_CTL) + 4096;
    if (G == 256) {
        const int jj = (bid >> 3) & 7, rank = ((bid >> 6) * 4 + (jj - 4)) * 8 + (bid & 7);
        const int extra = (jj >= 4 && rank < 64) ? 256 + rank : -1;
        {   pg8::Gemm g{H0, WIN0, NROW, ABIN, DM, DM, DM, 0}; pg8::CtxInOrder2 S{bid, extra};
            pg8::EpiZ0 E{Z0};
            pg8::gemm_phase<pg8::EpiZ0, pg8::CtxInOrder2, true, true>(ldsg, g, S, E); }
        asm volatile("s_waitcnt vmcnt(0)" ::: "memory");
        __syncthreads();
        if (threadIdx.x == 0) { __builtin_amdgcn_fence(__ATOMIC_RELEASE, "agent"); asm volatile("s_waitcnt vmcnt(0)" ::: "memory"); (void)xb_add(ctxflag + 64, extra >= 0 ? 2u : 1u); }
        if (jj >= 4 && rank >= 64) prep(1, rank - 64, 64);
        mixp::mixer_phase(lds_raw, Z0, WPOOL, WSGU, ab_pool_scale, ab_sgu_b, MIX0, ctxflag + 64, 320u, (unsigned*)(ws + OFF_CTL));
    } else {
        {   pg8::Gemm g{H0, WIN0, NROW, ABIN, DM, DM, DM, 0}; pg8::CtxInOrder S{G, bid};
            pg8::EpiZ0 E{Z0};
            pg8::gemm_phase<pg8::EpiZ0, pg8::CtxInOrder, true, true>(ldsg, g, S, E); }
        prep(3, bid, G);
        GRID_BAR();
        mixp::mixer_phase(lds_raw, Z0, WPOOL, WSGU, ab_pool_scale, ab_sgu_b, MIX0, nullptr, 0u, nullptr);
    }
    GRID_BAR();
    {   pg8::Gemm g{MIX0, WOUT0, NROW, DM, DM, DM, DM, 0}; pg8::CtxOutOrder S{G, bid};
        pg8::EpiOut0 E{x, ctx, MOD0, X1h, R0C};
        pg8::gemm_phase<pg8::EpiOut0, pg8::CtxOutOrder, true, true>(ldsg, g, S, E); }
    const bool early_ctx = (G == 256);
    if (early_ctx && bid < 128) {
        asm volatile("s_waitcnt vmcnt(0)" ::: "memory");
        __syncthreads();
        if (threadIdx.x == 0) { __builtin_amdgcn_fence(__ATOMIC_RELEASE, "agent"); asm volatile("s_waitcnt vmcnt(0)" ::: "memory"); (void)xb_add(ctxflag, 1u); }
    }
    for (int pm = bid; pm < 256; pm += G) {
        pg8::Gemm g{MIX0, WOUT0, NROW, DM, DM, DM, DM, 0}; pg8::PanelOrder S{pm};
        pg8::EpiOut0 E{x, ctx, MOD0, X1h, R0C};
        pg8::gemm_phase<pg8::EpiOut0, pg8::PanelOrder, true, true>(ldsg, g, S, E);
        ln0_rows(pm * 256, 256, X1h, 2048, ab_ln_g, ab_ln_b, MOD1, ST1, H1);
        __syncthreads();
    }
    if (early_ctx && bid >= 128 && bid < 160) {
        const int pc = bid - 128;
        if (threadIdx.x == 0) { unsigned* bar = (unsigned*)(ws + OFF_CTL); XB_SPIN(xb_ld(ctxflag) < 128u, bar); __builtin_amdgcn_fence(__ATOMIC_ACQUIRE, "agent"); asm volatile("s_waitcnt vmcnt(0)" ::: "memory"); }
        __syncthreads();
        ln0_rows(NLAT + pc * 256, 256, R0C - (size_t)NLAT * DM, DM, ab_ln_g, ab_ln_b, MOD1, ST1, H1);
        asm volatile("s_waitcnt vmcnt(0)" ::: "memory");
        __syncthreads();
        pg8::Gemm g{H1, WIN1, NROW, Z1LD, DM, DM, DM, 0}; pg8::CtxZ1One S{pc};
        pg8::EpiZ1 E{Z1, RQ, RKV, KR, ROPE};
        pg8::gemm_phase<pg8::EpiZ1, pg8::CtxZ1One, true, true>(ldsg, g, S, E);
    }
    if (early_ctx && bid >= 160) prep(2, bid - 160, G - 160);
    GRID_BAR();
    if (!early_ctx) {
        for (int pc = bid; pc < 32; pc += G) ln0_rows(NLAT + pc * 256, 256, R0C - (size_t)NLAT * DM, DM, ab_ln_g, ab_ln_b, MOD1, ST1, H1);
        GRID_BAR(); }
    const int vc = (G % 8 == 0) ? (bid % 8) * (G / 8) + bid / 8 : bid;
    {   pg8::Gemm g{H1, WIN1, NROW, Z1LD, DM, DM, DM, 0}; pg8::Z1Order S; S.init(G, early_ctx ? vc : bid, early_ctx ? 0 : 32);
        pg8::EpiZ1 E{Z1, RQ, RKV, KR, ROPE};
        pg8::gemm_phase<pg8::EpiZ1, pg8::Z1Order, true, true>(ldsg, g, S, E); }
    {   pg8::Gemm g{WIN1, H1, 512, NLAT, DM, DM, DM, 0}; pg8::FoldOrder S{G, vc};
        pg8::EpiFold E{FT, FT + (size_t)512 * NB * 1024};
        pg8::gemm_phase<pg8::EpiFold, pg8::FoldOrder, true, true>(ldsg, g, S, E); }
    GRID_BAR();
    {   pg8::Gemm g{DFT, FT, 2048, 32 * 512, 1024, 1024, NB * 1024, 0}; pg8::DftOrder S; S.init(G, vc);
        pg8::EpiDft E{SPEC};
        pg8::gemm_phase<pg8::EpiDft, pg8::DftOrder, true, true>(ldsg, g, S, E); }
    {   pg8::Gemm g{Z1 + 1280, WKV, NROW, 1024, 128, Z1LD, 256, 0};   pg8::StaticOrder S; S.init(NROW, 1024, G, bid);
        pg8::EpiRowScale E{KV, RKV, 1024, 0};
        pg8::gemm_phase<pg8::EpiRowScale, pg8::StaticOrder, true, true>(ldsg, g, S, E); }
    {   pg8::Gemm g{Z1 + 1024, WQ, NLAT, 768, 256, Z1LD, 256, 0}; pg8::StaticOrder S; S.init(NLAT, 768, G, bid);
        pg8::EpiQ E{Q, RQ, ROPE};
        pg8::gemm_phase<pg8::EpiQ, pg8::StaticOrder, true, true>(ldsg, g, S, E); }
    GRID_BAR();
    {   pg8::Gemm g{SPEC, WFN, NLAT / 2, DM, DM, DM, DM, 0}; pg8::YcOrder S{G, vc};
        pg8::EpiYc E{Z1, MIX1};
        pg8::gemm_phase<pg8::EpiYc, pg8::YcOrder, true, true>(ldsg, g, S, E); }
    {
        const int wv = threadIdx.x >> 6, lane = threadIdx.x & 63;
        for (int o = bid * 8 + wv; o < NB * 512; o += G * 8) {
            const int b = o >> 9, n = o & 511; const size_t row = (size_t)b * 2048 + 1024;
            float av[8], wv8[8]; { const v4u t0 = *(const v4u*)(SPEC + row * DM + 8 * lane); mixp::unpack8(t0, av); const v4u t1 = *(const v4u*)(WFN + (size_t)n * DM + 8 * lane); mixp::unpack8(t1, wv8); }
            float d = 0.f;
#pragma unroll
            for (int i = 0; i < 8; ++i) d += av[i] * wv8[i];
            d = wave_sum(d);
            if (lane == 0) MIX1[row * DM + n] = f2bf(d * pg8::silu_fast(bf2f(Z1[row * Z1LD + 512 + n])));
        }
    }
    att::attn_phase<0>(lds_raw, Q, KV, KR, Z1, MIX1);
    GRID_BAR();
    for (int pm = bid; pm < 256; pm += G) {
        pg8::Gemm g{MIX1, WOUT1, NLAT, DM, DM, DM, DM, 0}; pg8::PanelOrder S{pm};
        pg8::EpiOut1 E{MOD1, X1h, TEMP, ST1, ab_ln_g};
        pg8::gemm_phase<pg8::EpiOut1, pg8::PanelOrder, true, true>(ldsg, g, S, E);
        ln1_rows(pm * 256, 256, TEMP, ab_ln_b, cd_ln_g, cd_ln_b, out);
        __syncthreads();
    }
}


constexpr size_t LDS_BYTES = 136 * 1024;

extern "C" void kernel_launch(void* const* d_in, const int* in_sizes, int n_in, void* d_out, int out_size, void* d_ws, size_t ws_size, hipStream_t stream) {
    static int grid_blocks = 0;
    if (!grid_blocks) {
        int dev = 0, cus = 0, per_cu = 0;
        (void)hipGetDevice(&dev);
        (void)hipDeviceGetAttribute(&cus, hipDeviceAttributeMultiprocessorCount, dev);
        (void)hipFuncSetAttribute((const void*)mega, hipFuncAttributeMaxDynamicSharedMemorySize, (int)LDS_BYTES);
        (void)hipOccupancyMaxActiveBlocksPerMultiprocessor(&per_cu, (const void*)mega, NT, LDS_BYTES);
        if (per_cu < 1) per_cu = 1;
        if (per_cu > 1) per_cu = 1;
        grid_blocks = cus * per_cu;
        grid_blocks -= grid_blocks % 8;
    }
    if (ws_size < 960 * MiB) { fprintf(stderr, "workspace too small: %zu\n", ws_size); return; }
    Params p{};
    for (int i = 0; i < 25; ++i) p.in[i] = (const float*)d_in[i];
    p.out = (float*)d_out; p.ws = (char*)d_ws;
    (void)hipMemsetAsync((char*)d_ws + OFF_CTL, 0, CTL_BYTES, stream);
    void* args[] = {&p};
    hipError_t e = hipLaunchCooperativeKernel((const void*)mega, dim3(grid_blocks), dim3(NT), args, LDS_BYTES, stream);
    if (e != hipSuccess) fprintf(stderr, "cooperative launch failed: %s (grid %d)\n", hipGetErrorString(e), grid_blocks);
}
```
